# Optimizing an MI355X kernel written in HIP

```python
import math
import jax, jax.numpy as jnp
from jax import lax
import numpy as np

D_MODEL = 1024
BATCH = 16
SEQ = 256
DEPTH = 2
DEC_BATCH = 8
DEC_SEQ = 2048
PAST_LEN = 256

GRID_W = 64
N_MIXERS = 2
N_DIR = 2
N_HEADS = 8
HEAD_K = 128
HEAD_V = 128
KEY_DIM = N_HEADS * HEAD_K
VAL_DIM = N_HEADS * HEAD_V
QKV_DIM = 2 * KEY_DIM + VAL_DIM
GDN_PROJ = QKV_DIM + VAL_DIM + 2 * N_DIR * N_HEADS
HGRN_PROJ = KEY_DIM + N_DIR * KEY_DIM + 2 * VAL_DIM
CONV_W = 5
GDN_CHUNK = 64
HGRN_CHUNK = 16
D_FF = 4 * D_MODEL
N_GDN = (DEPTH + 1) // 2
N_HGRN = DEPTH // 2
EPS = 1e-6
STATE_SCALE = 0.5

kernel_name = 'hybrid_gdn_hgrn2_flow_step'


def rms_norm(x, g):
    x32 = x.astype(jnp.float32)
    y = x32 * lax.rsqrt(jnp.mean(x32 * x32, axis=-1, keepdims=True) + EPS)
    return (y * g.astype(jnp.float32)).astype(x.dtype)


def l2_normalise(x):
    return x * lax.rsqrt(jnp.sum(x * x, axis=-1, keepdims=True) + EPS)


def centred_conv(x, w):
    pad = CONV_W // 2
    n = x.shape[-2]
    xp = jnp.pad(x, [(0, 0)] * (x.ndim - 2) + [(pad, pad), (0, 0)])
    return sum(xp[..., j:j + n, :] * w[j] for j in range(CONV_W))


def token_conv(x, w, grid):
    if not grid:
        return centred_conv(x, w)
    b, t, ch = x.shape
    rows = t // GRID_W
    return centred_conv(x.reshape(b, rows, GRID_W, ch), w).reshape(b, t, ch)


def to_heads(x, d):
    b, t, _ = x.shape
    return x.reshape(b, t, N_HEADS, d).transpose(0, 2, 1, 3)


def to_chunks(x, c):
    return x.reshape(x.shape[:2] + (x.shape[2] // c, c) + x.shape[3:])


def gated_delta_chunk(q, k, v, g, beta, s0):
    out_dtype = v.dtype
    q, k, v, g, beta, s = (a.astype(jnp.float32) for a in (q, k, v, g, beta, s0))
    b, h, t, dk = q.shape
    c = GDN_CHUNK
    q = to_chunks(q * dk ** -0.5, c)
    k = to_chunks(k, c)
    v = to_chunks(v, c)
    g = jnp.cumsum(to_chunks(g, c), axis=-1)
    beta = to_chunks(beta, c)
    causal = jnp.tril(jnp.ones((c, c), dtype=bool))
    strict = jnp.tril(jnp.ones((c, c), jnp.float32), -1)
    decay = jnp.exp(jnp.where(causal, g[..., :, None] - g[..., None, :], -jnp.inf))
    kb = k * beta[..., None]
    lower = jnp.einsum('bhncd,bhnsd->bhncs', kb, k) * decay * strict
    eye = jnp.eye(c, dtype=jnp.float32)
    tmat = lax.linalg.triangular_solve(eye + lower, jnp.broadcast_to(eye, lower.shape), left_side=True, lower=True)
    u = jnp.einsum('bhncs,bhnse->bhnce', tmat, v * beta[..., None])
    w = jnp.einsum('bhncs,bhnsd->bhncd', tmat, kb * jnp.exp(g)[..., None])
    qk = jnp.einsum('bhncd,bhnsd->bhncs', q, k) * decay
    q_dec = q * jnp.exp(g)[..., None]
    k_tail = k * jnp.exp(g[..., -1:] - g)[..., None]
    g_last = jnp.exp(g[..., -1])

    def step(state, xs):
        w_n, u_n, qd_n, qk_n, kt_n, gl_n = xs
        v_new = u_n - jnp.einsum('bhcd,bhde->bhce', w_n, state)
        o_n = jnp.einsum('bhcd,bhde->bhce', qd_n, state) + jnp.einsum('bhcs,bhse->bhce', qk_n, v_new)
        state = state * gl_n[..., None, None] + jnp.einsum('bhcd,bhce->bhde', kt_n, v_new)
        return state, o_n

    xs = tuple(jnp.moveaxis(a, 2, 0) for a in (w, u, q_dec, qk, k_tail, g_last))
    s, o = lax.scan(step, s, xs)
    o = jnp.moveaxis(o, 0, 2).reshape(b, h, t, v.shape[-1])
    return o.astype(out_dtype), s.astype(s0.dtype)


def hgrn2_chunk(q, k, v, logf, s0):
    out_dtype = v.dtype
    q, k, v, logf, s = (a.astype(jnp.float32) for a in (q, k, v, logf, s0))
    b, h, t, _ = q.shape
    c = HGRN_CHUNK
    q, k, v, logf = (to_chunks(a, c) for a in (q, k, v, logf))
    bcum = jnp.cumsum(logf, axis=-2)
    q_in = q * jnp.exp(bcum)
    k_out = k * jnp.exp(-bcum)
    causal = jnp.tril(jnp.ones((c, c), dtype=bool))
    att = jnp.where(causal, jnp.einsum('bhncd,bhnsd->bhncs', q_in, k_out), 0.0)
    o_intra = jnp.einsum('bhncs,bhnse->bhnce', att, v)
    b_last = bcum[..., -1:, :]
    k_tail = k * jnp.exp(b_last - bcum)
    f_last = jnp.exp(b_last[..., 0, :])

    def step(state, xs):
        qi_n, kt_n, v_n, fl_n = xs
        o_n = jnp.einsum('bhcd,bhde->bhce', qi_n, state)
        state = state * fl_n[..., :, None] + jnp.einsum('bhcd,bhce->bhde', kt_n, v_n)
        return state, o_n

    xs = tuple(jnp.moveaxis(a, 2, 0) for a in (q_in, k_tail, v, f_last))
    s, o_inter = lax.scan(step, s, xs)
    o = o_intra + jnp.moveaxis(o_inter, 0, 2)
    return o.reshape(b, h, t, v.shape[-1]).astype(out_dtype), s.astype(s0.dtype)


def flip_t(a):
    return jnp.flip(a, axis=2)


def gated_deltanet_mixer(h, w_in, conv_w, a_log, dt_bias, onorm_g, w_out, s0, grid):
    b, t, _ = h.shape
    proj = h @ w_in
    qkv, z, braw, araw = jnp.split(proj, [QKV_DIM, QKV_DIM + VAL_DIM, QKV_DIM + VAL_DIM + N_DIR * N_HEADS], axis=-1)
    qkv = jax.nn.silu(token_conv(qkv, conv_w, grid))
    q, k, v = jnp.split(qkv, [KEY_DIM, 2 * KEY_DIM], axis=-1)
    q = l2_normalise(to_heads(q, HEAD_K).astype(jnp.float32))
    k = l2_normalise(to_heads(k, HEAD_K).astype(jnp.float32))
    v = to_heads(v, HEAD_V)
    beta = jax.nn.sigmoid(braw.astype(jnp.float32)).reshape(b, t, N_DIR, N_HEADS)
    g = -jnp.exp(a_log.astype(jnp.float32)) * jax.nn.softplus(
        araw.astype(jnp.float32).reshape(b, t, N_DIR, N_HEADS) + dt_bias.astype(jnp.float32))
    outs, finals = [], []
    for d in range(N_DIR):
        args = (q, k, v, g[:, :, d].transpose(0, 2, 1), beta[:, :, d].transpose(0, 2, 1))
        if d:
            args = tuple(flip_t(a) for a in args)
        o_d, s_d = gated_delta_chunk(*args, s0[:, d])
        outs.append(flip_t(o_d) if d else o_d)
        finals.append(s_d)
    o = rms_norm(outs[0] + outs[1], onorm_g) * jax.nn.silu(to_heads(z, HEAD_V))
    o = o.transpose(0, 2, 1, 3).reshape(b, t, VAL_DIM) @ w_out
    return o, jnp.stack(finals, axis=1)


def hgrn2_mixer(h, w_in, lb, onorm_g, w_out, s0):
    b, t, _ = h.shape
    proj = h @ w_in
    q, f, i, z = jnp.split(proj, [KEY_DIM, 3 * KEY_DIM, 3 * KEY_DIM + VAL_DIM], axis=-1)
    q = to_heads(jax.nn.silu(q), HEAD_K)
    v = to_heads(i, HEAD_V)
    fgate = lb + (1.0 - lb) * jax.nn.sigmoid(f.astype(jnp.float32).reshape(b, t, N_DIR, KEY_DIM))
    outs, finals = [], []
    for d in range(N_DIR):
        fd = to_heads(fgate[:, :, d], HEAD_K)
        args = (q, 1.0 - fd, v, jnp.log(fd))
        if d:
            args = tuple(flip_t(a) for a in args)
        o_d, s_d = hgrn2_chunk(*args, s0[:, d])
        outs.append(flip_t(o_d) if d else o_d)
        finals.append(s_d)
    o = rms_norm(outs[0] + outs[1], onorm_g) * jax.nn.silu(to_heads(z, HEAD_V))
    o = o.transpose(0, 2, 1, 3).reshape(b, t, VAL_DIM) @ w_out
    return o, jnp.stack(finals, axis=1)


def layer_lower_bounds(lb_logits):
    p = jax.nn.softmax(lb_logits.astype(jnp.float32), axis=0)
    return jnp.cumsum(p, axis=0) - p[0]


def run_trunk(x, cond, s_gdn, s_hgrn, grid, weights):
    (w_ada, b_ada, norm_g, gdn_w_in, gdn_conv_w, gdn_a_log, gdn_dt_bias, gdn_onorm_g, gdn_w_out,
     hgrn_w_in, hgrn_lb_logits, hgrn_onorm_g, hgrn_w_out, mlp_w1, mlp_w2) = weights
    lb_all = layer_lower_bounds(hgrn_lb_logits)
    cond_act = jax.nn.silu(cond)
    new_gdn, new_hgrn = [], []
    for layer in range(DEPTH):
        mod = (cond_act @ w_ada[layer] + b_ada[layer])[:, None, :]
        sh1, sc1, gt1, sh2, sc2, gt2 = jnp.split(mod, 6, axis=-1)
        hmod = rms_norm(x, norm_g[layer, 0]) * (1.0 + sc1) + sh1
        j = layer // N_MIXERS
        if layer % N_MIXERS == 0:
            mix, s_fin = gated_deltanet_mixer(hmod, gdn_w_in[j], gdn_conv_w[j], gdn_a_log[j], gdn_dt_bias[j],
                                              gdn_onorm_g[j], gdn_w_out[j], s_gdn[:, j], grid)
            new_gdn.append(s_fin)
        else:
            mix, s_fin = hgrn2_mixer(hmod, hgrn_w_in[j], lb_all[layer], hgrn_onorm_g[j], hgrn_w_out[j], s_hgrn[:, j])
            new_hgrn.append(s_fin)
        x = x + gt1 * rms_norm(mix, norm_g[layer, 1])
        hmod = rms_norm(x, norm_g[layer, 2]) * (1.0 + sc2) + sh2
        ff = jnp.square(jax.nn.relu(hmod @ mlp_w1[layer])) @ mlp_w2[layer]
        x = x + gt2 * rms_norm(ff, norm_g[layer, 3])
    return x, jnp.stack(new_gdn, axis=1), jnp.stack(new_hgrn, axis=1)


def setup_inputs(seed: int = 0) -> dict:
    key = jax.random.key(seed)
    ks = jax.random.split(key, 22)
    f32 = jnp.float32

    def nrm(k, shape, scale):
        return jax.random.normal(k, shape, f32) * scale

    dt = jnp.exp(jax.random.uniform(ks[12], (N_GDN, N_DIR, N_HEADS), f32, math.log(1e-3), math.log(1e-1)))
    return {
        'x_prompt': nrm(ks[0], (BATCH, SEQ, D_MODEL), 1.0),
        'x_sample': nrm(ks[1], (DEC_BATCH, DEC_SEQ, D_MODEL), 1.0),
        'state_gdn': nrm(ks[2], (DEC_BATCH, N_GDN, N_DIR, N_HEADS, HEAD_K, HEAD_V), STATE_SCALE),
        'state_hgrn': nrm(ks[3], (DEC_BATCH, N_HGRN, N_DIR, N_HEADS, HEAD_K, HEAD_V), STATE_SCALE),
        'c': nrm(ks[4], (DEC_BATCH, D_MODEL), 1.0),
        'c_ctx': nrm(ks[5], (D_MODEL,), 1.0),
        'w_ada': nrm(ks[6], (DEPTH, D_MODEL, 6 * D_MODEL), 0.5 * D_MODEL ** -0.5),
        'b_ada': nrm(ks[7], (DEPTH, 6 * D_MODEL), 0.02),
        'norm_g': 1.0 + nrm(ks[8], (DEPTH, 4, D_MODEL), 0.05),
        'gdn_w_in': nrm(ks[9], (N_GDN, D_MODEL, GDN_PROJ), D_MODEL ** -0.5),
        'gdn_conv_w': nrm(ks[10], (N_GDN, CONV_W, QKV_DIM), CONV_W ** -0.5),
        'gdn_a_log': jnp.log(jax.random.uniform(ks[11], (N_GDN, N_DIR, N_HEADS), f32, 1.0, 16.0)),
        'gdn_dt_bias': dt + jnp.log(-jnp.expm1(-dt)),
        'gdn_onorm_g': 1.0 + nrm(ks[13], (N_GDN, HEAD_V), 0.05),
        'gdn_w_out': nrm(ks[14], (N_GDN, VAL_DIM, D_MODEL), VAL_DIM ** -0.5),
        'hgrn_w_in': nrm(ks[15], (N_HGRN, D_MODEL, HGRN_PROJ), D_MODEL ** -0.5),
        'hgrn_lb_logits': nrm(ks[16], (DEPTH, N_DIR, KEY_DIM), 0.5),
        'hgrn_onorm_g': 1.0 + nrm(ks[17], (N_HGRN, HEAD_V), 0.05),
        'hgrn_w_out': nrm(ks[18], (N_HGRN, VAL_DIM, D_MODEL), VAL_DIM ** -0.5),
        'mlp_w1': nrm(ks[19], (DEPTH, D_MODEL, D_FF), D_MODEL ** -0.5),
        'mlp_w2': nrm(ks[20], (DEPTH, D_FF, D_MODEL), D_FF ** -0.5),
    }


def reference(x_prompt, x_sample, state_gdn, state_hgrn, c, c_ctx, w_ada, b_ada, norm_g,
              gdn_w_in, gdn_conv_w, gdn_a_log, gdn_dt_bias, gdn_onorm_g, gdn_w_out,
              hgrn_w_in, hgrn_lb_logits, hgrn_onorm_g, hgrn_w_out, mlp_w1, mlp_w2):
    weights = (w_ada, b_ada, norm_g, gdn_w_in, gdn_conv_w, gdn_a_log, gdn_dt_bias, gdn_onorm_g, gdn_w_out,
               hgrn_w_in, hgrn_lb_logits, hgrn_onorm_g, hgrn_w_out, mlp_w1, mlp_w2)
    nb = x_prompt.shape[0]
    zeros_gdn = jnp.zeros((nb, N_GDN, N_DIR, N_HEADS, HEAD_K, HEAD_V), x_prompt.dtype)
    zeros_hgrn = jnp.zeros((nb, N_HGRN, N_DIR, N_HEADS, HEAD_K, HEAD_V), x_prompt.dtype)
    y_prompt, new_state_gdn, new_state_hgrn = run_trunk(x_prompt, c_ctx[None, :], zeros_gdn, zeros_hgrn, False, weights)
    y_sample, _, _ = run_trunk(x_sample, c, state_gdn, state_hgrn, True, weights)
    return (y_prompt, y_sample, new_state_gdn, new_state_hgrn)
```

```cpp
#include <hip/hip_runtime.h>
#include <hip/hip_cooperative_groups.h>
#include <cstdio>
#include <cstdint>
namespace cg = cooperative_groups;
#ifndef PROBE_GEMM2
#define PROBE_GEMM2 0
#endif
#ifndef PROBE_GDN2
#define PROBE_GDN2 0
#endif
#ifndef PROBE_HGRN2
#define PROBE_HGRN2 0
#endif
#ifndef PROBE_GCONV2
#define PROBE_GCONV2 0
#endif
#ifndef PROBE_GSOLVE2
#define PROBE_GSOLVE2 0
#endif
#ifndef PROBE_SYNC2
#define PROBE_SYNC2 0
#endif
namespace pg8 {
#define PG8_LAS __attribute__((address_space(3)))
typedef unsigned short bf16_t;
typedef short bf16x8 __attribute__((ext_vector_type(8)));
typedef float f32x4 __attribute__((ext_vector_type(4)));
typedef unsigned u32x4 __attribute__((ext_vector_type(4)));
constexpr int BM = 256, BK = 64, HALF = 128, HTB = HALF * BK * 2  , STAGE_BYTES = 8 * HTB, NXCD = 8, WGM = 8;

__host__ __device__ __forceinline__ int lds_byte(int r, int c) { const int st = (r >> 4) * 2 + (c >> 5), rr = r & 15, cc = c & 31, ob = rr * 64 + cc * 2; return st * 1024 + (ob ^ (((ob >> 9) & 1) << 5)); }
__host__ __device__ __forceinline__ void stage_rc(int b, int& R, int& C) { const int st = b / 1024, sb = b % 1024, swz = sb ^ (((sb >> 9) & 1) << 5); R = (st >> 1) * 16 + swz / 64; C = (st & 1) * 32 + (swz % 64) / 2; }
__host__ __device__ __forceinline__ int perm32(int rho) { const int n = rho >> 4, i = rho & 15; return 8 * (i >> 2) + 4 * n + (i & 3); }

struct Unit { int pm, pn; };
struct Gemm { const bf16_t* A; const bf16_t* Bt; int M, N, K; };

struct StaticOrder {
    int nM, nN, nwg, G, c;
    __host__ __device__ void init(int M, int N, int G_, int c_) { nM = M / BM; nN = N / BM; nwg = nM * nN; G = G_; c = c_; }
    __host__ __device__ bool next(int i, Unit& u) const {
        const long L = (long)i * G + c; if (L >= nwg) return false;
        int wgid = (int)L; { const int q = nwg / NXCD, r = nwg % NXCD, xcd = wgid % NXCD, off = wgid / NXCD; wgid = (xcd < r ? xcd * (q + 1) : r * (q + 1) + (xcd - r) * q) + off; }
        if (nN == 4) { u.pm = wgid >> 2; u.pn = wgid & 3; return true; }
        const int nig = WGM * nN, gid = wgid / nig, fm = gid * WGM, gsz = (nM - fm) < WGM ? (nM - fm) : WGM;
        u.pm = fm + ((wgid % nig) % gsz); u.pn = (wgid % nig) / gsz; return true;
    }
    __device__ __forceinline__ void a_ready(const Unit&) const {}
    __device__ __forceinline__ void done(const Unit&) const {}
};

typedef __bf16 b16x2v __attribute__((ext_vector_type(2)));
typedef float f32x2 __attribute__((ext_vector_type(2)));
__device__ __forceinline__ unsigned cvt_pk_bf16(float lo, float hi) { f32x2 v = {lo, hi}; b16x2v r = __builtin_convertvector(v, b16x2v); return __builtin_bit_cast(unsigned, r); }
template <int ACT  > struct EpiBf16 {
    static constexpr bool PERM = true, AFTER_DRAIN = false;
    bf16_t* O; int ldc; const float* aux;
    __device__ __forceinline__ static float silu1(float x) { return x * __builtin_amdgcn_rcpf(1.f + __expf(-x)); }
    __device__ __forceinline__ void operator()(const f32x4 (&acc)[2][2][4][2], const Unit& u, int wr, int wc, int fr, int fq) const {
        const int row0 = u.pm * BM + wr * 64 + fr; const int col0 = u.pn * BM + wc * 32 + 8 * fq;
        const bool do_silu = (ACT == 3) ? (u.pn >= 12 && u.pn < 16) : (ACT == 4) ? (u.pn < 4 || u.pn >= 16) : false;
        const bool do_logf = (ACT == 4) && (u.pn >= 4 && u.pn < 12);
        float lb[2][8];
        if (ACT == 4) { if (do_logf) {
#pragma unroll
            for (int bj = 0; bj < 2; ++bj)
#pragma unroll
                for (int e = 0; e < 8; ++e) { const int k = col0 + bj * HALF + e - 1024; lb[bj][e] = __builtin_amdgcn_rcpf(1.f + __expf(aux[k] - aux[2048 + k])); } } }
#pragma unroll
        for (int ai = 0; ai < 2; ++ai)
#pragma unroll
            for (int m = 0; m < 4; ++m) { bf16_t* rowp = O + (size_t)(row0 + ai * HALF + m * 16) * ldc + col0;
#pragma unroll
                for (int bj = 0; bj < 2; ++bj) { f32x4 v0 = acc[ai][bj][m][0], v1 = acc[ai][bj][m][1];
                    if (ACT == 2) {
#pragma unroll
                        for (int e = 0; e < 4; ++e) { const float a = v0[e] > 0.f ? v0[e] : 0.f, b = v1[e] > 0.f ? v1[e] : 0.f; v0[e] = a * a; v1[e] = b * b; } }
                    if (ACT == 3 || ACT == 4) { if (do_silu) {
#pragma unroll
                        for (int e = 0; e < 4; ++e) { v0[e] = silu1(v0[e]); v1[e] = silu1(v1[e]); } } }
                    if (ACT == 4) { if (do_logf) {
#pragma unroll
                        for (int e = 0; e < 4; ++e) { const float l0 = lb[bj][e], l1 = lb[bj][4 + e];
                            v0[e] = l0 + (1.f - l0) * __builtin_amdgcn_rcpf(1.f + __expf(-v0[e])); v1[e] = l1 + (1.f - l1) * __builtin_amdgcn_rcpf(1.f + __expf(-v1[e])); } } }
                    u32x4 w; w.x = cvt_pk_bf16(v0[0], v0[1]); w.y = cvt_pk_bf16(v0[2], v0[3]); w.z = cvt_pk_bf16(v1[0], v1[1]); w.w = cvt_pk_bf16(v1[2], v1[3]);
                    *(u32x4*)(rowp + bj * HALF) = w; } }
    }
};

template <class Epi, class Sched, bool ALIGN_EPI = false, bool SP2 = false>
__device__ __forceinline__ void gemm_phase(PG8_LAS unsigned char* lds, const Gemm g, const Sched& S, const Epi& E) {
    int tid_ = threadIdx.x; asm volatile("" : "+v"(tid_));
    const int tid = tid_, wid = __builtin_amdgcn_readfirstlane(tid >> 6), lane = tid & 63, wr = wid >> 2, wc = wid & 3, fr = lane & 15, fq = lane >> 4;
    const int K = g.K, nt = K / BK;
    unsigned voffA[2], voffB[2];
#pragma unroll
    for (int i = 0; i < 2; ++i) { int R, C; stage_rc(tid * 16 + i * 8192, R, C); const int Rb = Epi::PERM ? ((R & ~31) + perm32(R & 31)) : R;
        voffA[i] = (unsigned)(R * K + C) * 2u; voffB[i] = (unsigned)(Rb * K + C) * 2u; }
    const size_t kstep = (size_t)(BK * 2);
    const size_t hstep = (size_t)HALF * K * 2;
    const size_t tstep = 2 * hstep;
    const unsigned ldsw = (unsigned)wid * 1024u;
    const int aoff = lds_byte(wr * 64 + fr, fq * 8), boff = lds_byte(wc * 32 + fr, fq * 8);
#define PG8_SA(b, h) (((b) * 2 + (h)) * HTB)
#define PG8_SB(b, h) ((4 + (b) * 2 + (h)) * HTB)
#define PG8_STAGE(bufoff, gbase, voff) do { _Pragma("unroll") for (int _i = 0; _i < 2; ++_i) \
        __builtin_amdgcn_global_load_lds((const unsigned*)((const char*)(gbase) + (voff)[_i]), (PG8_LAS unsigned*)(lds + (bufoff) + ldsw + _i * 8192), 16, 0, 0); } while (0)
#define PG8_LDA(dst, b, h) do { _Pragma("unroll") for (int m = 0; m < 4; ++m) _Pragma("unroll") for (int k = 0; k < 2; ++k) dst[m][k] = *(const PG8_LAS bf16x8*)(lds + PG8_SA(b, h) + aoff + m * 2048 + k * 1024); } while (0)
#define PG8_LDB(dst, b, h) do { _Pragma("unroll") for (int n = 0; n < 2; ++n) _Pragma("unroll") for (int k = 0; k < 2; ++k) dst[n][k] = *(const PG8_LAS bf16x8*)(lds + PG8_SB(b, h) + boff + n * 2048 + k * 1024); } while (0)
#define PG8_MMA(ai, bj, At, Bt) do { __builtin_amdgcn_s_setprio(1); _Pragma("unroll") for (int m = 0; m < 4; ++m) _Pragma("unroll") for (int n = 0; n < 2; ++n) _Pragma("unroll") for (int k = 0; k < 2; ++k) \
        acc[ai][bj][m][n] = __builtin_amdgcn_mfma_f32_16x16x32_bf16(Bt[n][k], At[m][k], acc[ai][bj][m][n], 0, 0, 0); __builtin_amdgcn_s_setprio(0); } while (0)
#define PG8_WAIT_V(n) asm volatile("s_waitcnt vmcnt(" #n ")" ::: "memory")
#define PG8_WAIT_L(n) asm volatile("s_waitcnt lgkmcnt(" #n ")" ::: "memory")
#define PG8_BAR __builtin_amdgcn_s_barrier()
#define PG8_SCHED __builtin_amdgcn_sched_barrier(0)
    Unit cur, nxt; int ui = 0;
    if (!S.next(0, cur)) return;
    f32x4 acc[2][2][4][2];
#pragma unroll
    for (int a = 0; a < 2; ++a)
#pragma unroll
        for (int b = 0; b < 2; ++b)
#pragma unroll
            for (int m = 0; m < 4; ++m)
#pragma unroll
                for (int n = 0; n < 2; ++n) acc[a][b][m][n] = (f32x4){0.f, 0.f, 0.f, 0.f};
    bf16x8 At[4][2], B0[2][2], B1[2][2];
    const char* cA = (const char*)g.A + (size_t)cur.pm * tstep; const char* cB = (const char*)g.Bt + (size_t)cur.pn * tstep;
    S.a_ready(cur);
    if constexpr (SP2) {
        PG8_STAGE(PG8_SB(0, 0), cB, voffB); PG8_STAGE(PG8_SB(0, 1), cB + hstep, voffB); PG8_STAGE(PG8_SA(0, 0), cA, voffA); PG8_STAGE(PG8_SA(0, 1), cA + hstep, voffA);
        if (wr == 1) PG8_BAR;
        PG8_WAIT_V(2); PG8_BAR;
        PG8_STAGE(PG8_SB(1, 0), cB + kstep, voffB); PG8_STAGE(PG8_SA(1, 0), cA + kstep, voffA); PG8_STAGE(PG8_SB(1, 1), cB + hstep + kstep, voffB);
        PG8_WAIT_V(6); PG8_BAR;
    } else {
        PG8_STAGE(PG8_SB(0, 0), cB, voffB); PG8_STAGE(PG8_SA(0, 0), cA, voffA); PG8_STAGE(PG8_SB(0, 1), cB + hstep, voffB); PG8_STAGE(PG8_SA(0, 1), cA + hstep, voffA);
        if (wr == 1) PG8_BAR;
        PG8_WAIT_V(4); PG8_BAR;
        PG8_STAGE(PG8_SB(1, 0), cB + kstep, voffB); PG8_STAGE(PG8_SA(1, 0), cA + kstep, voffA); PG8_STAGE(PG8_SB(1, 1), cB + hstep + kstep, voffB);
        PG8_WAIT_V(6); PG8_BAR;
    }
    for (;;) {
        const bool has_next = S.next(ui + 1, nxt);
        const char* nA = has_next ? (const char*)g.A + (size_t)nxt.pm * tstep : cA; const char* nB = has_next ? (const char*)g.Bt + (size_t)nxt.pn * tstep : cB;
        for (int t = 0; t < nt; t += 2) {
            const bool last = (t == nt - 2);
            const char* a1 = cA + (size_t)(t + 1) * kstep;
            const char* a2 = last ? nA : cA + (size_t)(t + 2) * kstep; const char* b2 = last ? nB : cB + (size_t)(t + 2) * kstep;
            const char* a3 = a2 + kstep; const char* b3 = b2 + kstep;
            if (last && has_next) S.a_ready(nxt);
            if constexpr (SP2) {
            PG8_LDB(B0, 0, 0); PG8_LDB(B1, 0, 1); PG8_SCHED; PG8_LDA(At, 0, 0); PG8_STAGE(PG8_SA(1, 1), a1 + hstep, voffA);
            PG8_WAIT_V(8); PG8_WAIT_L(0); PG8_BAR; PG8_MMA(0, 0, At, B0); PG8_MMA(0, 1, At, B1); PG8_BAR; PG8_SCHED;
            PG8_LDA(At, 0, 1); PG8_STAGE(PG8_SB(0, 0), b2, voffB); PG8_STAGE(PG8_SB(0, 1), b2 + hstep, voffB); PG8_STAGE(PG8_SA(0, 0), a2, voffA);
            PG8_WAIT_V(8); PG8_WAIT_L(0); PG8_BAR; PG8_MMA(1, 0, At, B0); PG8_MMA(1, 1, At, B1); PG8_BAR; PG8_SCHED;
            PG8_LDB(B0, 1, 0); PG8_LDB(B1, 1, 1); PG8_SCHED; PG8_LDA(At, 1, 0); PG8_STAGE(PG8_SA(0, 1), a2 + hstep, voffA);
            PG8_WAIT_V(8); PG8_WAIT_L(0); PG8_BAR; PG8_MMA(0, 0, At, B0); PG8_MMA(0, 1, At, B1); PG8_BAR; PG8_SCHED;
            PG8_LDA(At, 1, 1); PG8_STAGE(PG8_SB(1, 0), b3, voffB); PG8_STAGE(PG8_SB(1, 1), b3 + hstep, voffB); PG8_STAGE(PG8_SA(1, 0), a3, voffA);
            PG8_WAIT_V(8); PG8_WAIT_L(0); PG8_BAR; PG8_MMA(1, 0, At, B0); PG8_MMA(1, 1, At, B1); PG8_BAR; PG8_SCHED;
            } else {
            PG8_LDB(B0, 0, 0); PG8_SCHED; PG8_LDA(At, 0, 0); PG8_STAGE(PG8_SA(1, 1), a1 + hstep, voffA);
            PG8_WAIT_L(8); PG8_BAR; PG8_WAIT_L(0); PG8_MMA(0, 0, At, B0); PG8_BAR; PG8_SCHED;
            PG8_LDB(B1, 0, 1); PG8_STAGE(PG8_SB(0, 0), b2, voffB);
            PG8_BAR; PG8_WAIT_L(0); PG8_MMA(0, 1, At, B1); PG8_BAR;
            PG8_LDA(At, 0, 1); PG8_STAGE(PG8_SA(0, 0), a2, voffA);
            PG8_BAR; PG8_WAIT_L(0); PG8_MMA(1, 0, At, B0); PG8_BAR; PG8_SCHED;
            PG8_STAGE(PG8_SB(0, 1), b2 + hstep, voffB);
            PG8_WAIT_V(6); PG8_BAR; PG8_MMA(1, 1, At, B1); PG8_BAR;
            PG8_LDB(B0, 1, 0); PG8_SCHED; PG8_LDA(At, 1, 0); PG8_STAGE(PG8_SA(0, 1), a2 + hstep, voffA);
            PG8_WAIT_L(8); PG8_BAR; PG8_WAIT_L(0); PG8_MMA(0, 0, At, B0); PG8_BAR; PG8_SCHED;
            PG8_LDB(B1, 1, 1); PG8_STAGE(PG8_SB(1, 0), b3, voffB);
            PG8_BAR; PG8_WAIT_L(0); PG8_MMA(0, 1, At, B1); PG8_BAR;
            PG8_LDA(At, 1, 1); PG8_STAGE(PG8_SA(1, 0), a3, voffA);
            PG8_BAR; PG8_WAIT_L(0); PG8_MMA(1, 0, At, B0); PG8_BAR; PG8_SCHED;
            PG8_STAGE(PG8_SB(1, 1), b3 + hstep, voffB);
            PG8_WAIT_V(6); PG8_BAR; PG8_MMA(1, 1, At, B1); PG8_BAR;
            }
        }
        if constexpr (ALIGN_EPI) { if (wr == 0) PG8_BAR; }
        if constexpr (!Epi::AFTER_DRAIN) { E(acc, cur, wr, wc, fr, fq); S.done(cur); }
        if (!has_next) break;
#pragma unroll
        for (int a = 0; a < 2; ++a)
#pragma unroll
            for (int b = 0; b < 2; ++b)
#pragma unroll
                for (int m = 0; m < 4; ++m)
#pragma unroll
                    for (int n = 0; n < 2; ++n) acc[a][b][m][n] = (f32x4){0.f, 0.f, 0.f, 0.f};
        cur = nxt; cA = nA; cB = nB; ++ui;
        if constexpr (ALIGN_EPI) { if (wr == 1) PG8_BAR; }
    }
    PG8_WAIT_V(0);
    if constexpr (!ALIGN_EPI) { if (wr == 0) PG8_BAR; }
    PG8_BAR;
    if constexpr (Epi::AFTER_DRAIN) { E.fused(acc, cur, wr, wc, fr, fq, lds, wid, lane); S.done(cur); }
#undef PG8_SA
#undef PG8_SB
#undef PG8_STAGE
#undef PG8_LDA
#undef PG8_LDB
#undef PG8_MMA
#undef PG8_WAIT_V
#undef PG8_WAIT_L
#undef PG8_BAR
#undef PG8_SCHED
}
}
#define LAS __attribute__((address_space(3)))
typedef unsigned short bf16_t;
typedef float f32x4 __attribute__((ext_vector_type(4)));
typedef float f32x2 __attribute__((ext_vector_type(2)));
typedef short s16x4 __attribute__((ext_vector_type(4)));
typedef short bf16x8 __attribute__((ext_vector_type(8)));
typedef unsigned u32x4 __attribute__((ext_vector_type(4)));
typedef unsigned u32x2 __attribute__((ext_vector_type(2)));
typedef __bf16 b16x2 __attribute__((ext_vector_type(2)));

constexpr int NT = 20480, NPR = 4096, DM = 1024, TS = 2048, TP = 256;
constexpr int LDS_BYTES = 151552;
constexpr int NTHREADS = 512;
constexpr size_t MiB = (size_t)1 << 20;
constexpr int LD0 = 4352, LD1 = 5120;
constexpr size_t WS_BIG = 0, WS_160 = 160 * MiB, WS_168 = 168 * MiB, WS_170 = 170 * MiB, WS_200 = 200 * MiB, WS_210 = 210 * MiB, WS_240 = 240 * MiB;
constexpr size_t WS_BAR = 255 * MiB, BAR_BYTES = 16384;
constexpr size_t WS_WOUT0 = 250 * MiB, WS_WOUT1 = 252 * MiB, WS_MOD = 254 * MiB, WS_NEED = 256 * MiB;
constexpr size_t OUT_SG = (size_t)NT * DM, OUT_SH = OUT_SG + (size_t)16 * 2 * 8 * 128 * 128;
constexpr float EPSF = 1e-6f;

struct Params { const float* in[21]; float* out; unsigned char* ws; };
typedef const __attribute__((address_space(4))) Params* CPP;
#define FRESH(q) asm volatile("" : "+s"(q))

__device__ __forceinline__ float bf2f(unsigned v) { return __uint_as_float(v << 16); }
__device__ __forceinline__ unsigned pk2(float lo, float hi) { f32x2 v = {lo, hi}; b16x2 r = __builtin_convertvector(v, b16x2); return __builtin_bit_cast(unsigned, r); }
__device__ __forceinline__ s16x4 pk4(f32x4 v) { u32x2 r; r.x = pk2(v[0], v[1]); r.y = pk2(v[2], v[3]); return __builtin_bit_cast(s16x4, r); }
__device__ __forceinline__ f32x4 unpk4(s16x4 v) { u32x2 r = __builtin_bit_cast(u32x2, v); f32x4 o; o[0] = __uint_as_float(r.x << 16); o[1] = __uint_as_float(r.x & 0xffff0000u); o[2] = __uint_as_float(r.y << 16); o[3] = __uint_as_float(r.y & 0xffff0000u); return o; }
__device__ __forceinline__ float silu_f(float x) { return x * __builtin_amdgcn_rcpf(1.f + __expf(-x)); }
__device__ __forceinline__ float sigmoid_f(float x) { return __builtin_amdgcn_rcpf(1.f + __expf(-x)); }
__device__ __forceinline__ f32x4 mfma16(s16x4 a, s16x4 b, f32x4 c) { return __builtin_amdgcn_mfma_f32_16x16x16bf16_1k(a, b, c, 0, 0, 0); }
__device__ __forceinline__ f32x4 mfma32(bf16x8 a, bf16x8 b, f32x4 c) { return __builtin_amdgcn_mfma_f32_16x16x32_bf16(a, b, c, 0, 0, 0); }
#define BLOCK_SYNC() __syncthreads()
#define LDS_SYNC() do { asm volatile("s_waitcnt lgkmcnt(0)" ::: "memory"); __builtin_amdgcn_s_barrier(); asm volatile("" ::: "memory"); } while (0)

__device__ __forceinline__ void transpose_item(const float* W, int K, int N, bf16_t* WT, LAS float* scr, int item, int lane) {
    const int nblk = N / 32, kb = item / nblk, nb = item % nblk, k0 = 64 * kb, n0 = 32 * nb;
#pragma unroll 8
    for (int i = 0; i < 32; ++i) { const int kk = 2 * i + (lane >> 5); scr[kk * 33 + (lane & 31)] = W[(size_t)(k0 + kk) * N + n0 + (lane & 31)]; }
    asm volatile("s_waitcnt lgkmcnt(0)" ::: "memory");
    const int c = lane & 7;
#pragma unroll
    for (int j = 0; j < 4; ++j) { const int n = (lane >> 3) + 8 * j; const LAS float* s = scr + (8 * c) * 33 + n;
        u32x4 o; o.x = pk2(s[0 * 33], s[1 * 33]); o.y = pk2(s[2 * 33], s[3 * 33]); o.z = pk2(s[4 * 33], s[5 * 33]); o.w = pk2(s[6 * 33], s[7 * 33]);
        *(u32x4*)(WT + (size_t)(n0 + n) * K + k0 + 8 * c) = o; }
    asm volatile("s_waitcnt lgkmcnt(0)" ::: "memory");
}
__device__ __forceinline__ void convert_matrix(const float* W, int K, int N, bf16_t* WT, LAS float* scr, int gw, int ngw, int lane) {
    const int nitems = (K / 64) * (N / 32);
    for (int it = gw; it < nitems; it += ngw) transpose_item(W, K, N, WT, scr, it, lane);
}

__device__ __forceinline__ void mod_item(CPP P, LAS unsigned char* lds, int item) {
    int tid_ = threadIdx.x; asm volatile("" : "+v"(tid_)); const int tid = tid_, lane = tid & 63, w = tid >> 6;
    const int layer = item / 96, cb = item % 96, n0 = cb * 64;
    LAS float* ca = (LAS float*)lds;
    LAS float* red = (LAS float*)(lds + 36864);
    const float* c = P->in[4]; const float* cctx = P->in[5];
    for (int i = tid; i < 9 * 1024; i += NTHREADS) { const float v = (i < 1024) ? cctx[i] : c[i - 1024]; ca[i] = silu_f(v); }
    BLOCK_SYNC();
    const float* wp = P->in[6] + (size_t)layer * 1024 * 6144 + n0 + lane;
    float acc[9];
#pragma unroll
    for (int r = 0; r < 9; ++r) acc[r] = 0.f;
#pragma unroll 8
    for (int k = 128 * w; k < 128 * w + 128; ++k) { const float wv = wp[(size_t)k * 6144];
#pragma unroll
        for (int r = 0; r < 9; ++r) acc[r] += ca[r * 1024 + k] * wv; }
#pragma unroll
    for (int r = 0; r < 9; ++r) red[(w * 9 + r) * 64 + lane] = acc[r];
    BLOCK_SYNC();
    float* mod = (float*)(P->ws + WS_MOD);
    for (int idx = tid; idx < 9 * 64; idx += NTHREADS) { const int r = idx >> 6, l = idx & 63; float s = 0.f;
#pragma unroll
        for (int ww = 0; ww < 8; ++ww) s += red[(ww * 9 + r) * 64 + l];
        mod[(size_t)(layer * 9 + r) * 6144 + n0 + l] = s + P->in[7][layer * 6144 + n0 + l]; }
    BLOCK_SYNC();
}

struct EwArgs { const float* xin_p; const float* xin_s; float* X; int xb_in, xb_out;
                const bf16_t* Y; int ldy; const float* gy; const float* mod_y; int gate_off;
                const float* gh; const float* mod_h; int sc_off, sh_off; bf16_t* H; };
__device__ __forceinline__ float wave_sum(float v) {
    int x_;
#define DPPADD(ctrl, rmask) do { x_ = __builtin_amdgcn_update_dpp(0, __float_as_int(v), (ctrl), (rmask), 0xf, false); v += __int_as_float(x_); } while (0)
    DPPADD(0x111, 0xf); DPPADD(0x112, 0xf); DPPADD(0x114, 0xf); DPPADD(0x118, 0xf); DPPADD(0x142, 0xa); DPPADD(0x143, 0xc);
#undef DPPADD
    return __int_as_float(__builtin_amdgcn_readlane(__float_as_int(v), 63));
}
template <int XIN  , int XOUT  >
__device__ __forceinline__ void ew_phase(const EwArgs& A, int gw, int ngw, int lane) {
    const int per = (NT + ngw - 1) / ngw; const int mbeg = gw * per, mend = (mbeg + per < NT) ? mbeg + per : NT;
    f32x4 gyv[4], ghv[4], gtv[4], scv[4], shv[4];
#pragma unroll
    for (int j = 0; j < 4; ++j) { gyv[j] = A.Y ? *(const f32x4*)(A.gy + 4 * lane + 256 * j) : (f32x4){0.f, 0.f, 0.f, 0.f}; ghv[j] = A.H ? *(const f32x4*)(A.gh + 4 * lane + 256 * j) : (f32x4){0.f, 0.f, 0.f, 0.f};
        gtv[j] = (f32x4){0.f, 0.f, 0.f, 0.f}; scv[j] = gtv[j]; shv[j] = gtv[j]; }
    f32x4 cxf[4], nxf[4]; u32x2 cxb[4], nxb[4], cy[4], ny[4];
#define EW_LOADROW(mm, xf, xbv, yv) do { const int m_ = (mm); \
        if (XIN == 1) { const bf16_t* xb_ = (const bf16_t*)A.X + (size_t)m_ * 2048 + 1024; _Pragma("unroll") for (int j = 0; j < 4; ++j) xbv[j] = *(const u32x2*)(xb_ + 4 * lane + 256 * j); } \
        else { const float* xr_ = (m_ < NPR) ? A.xin_p + (size_t)m_ * DM : A.xin_s + (size_t)(m_ - NPR) * DM; _Pragma("unroll") for (int j = 0; j < 4; ++j) xf[j] = *(const f32x4*)(xr_ + 4 * lane + 256 * j); } \
        if (A.Y) { _Pragma("unroll") for (int j = 0; j < 4; ++j) yv[j] = *(const u32x2*)(A.Y + (size_t)m_ * A.ldy + 4 * lane + 256 * j); } } while (0)
    if (mbeg < mend) EW_LOADROW(mbeg, cxf, cxb, cy);
    int rcur = -1;
    for (int m = mbeg; m < mend; ++m) {
        if (m + 1 < mend) EW_LOADROW(m + 1, nxf, nxb, ny);
        const int r = (m < NPR) ? 0 : 1 + ((m - NPR) >> 11);
        if (r != rcur) { rcur = r;
#pragma unroll
            for (int j = 0; j < 4; ++j) { if (A.Y) gtv[j] = *(const f32x4*)(A.mod_y + (size_t)r * 6144 + A.gate_off + 4 * lane + 256 * j);
                if (A.H) { scv[j] = *(const f32x4*)(A.mod_h + (size_t)r * 6144 + A.sc_off + 4 * lane + 256 * j); shv[j] = *(const f32x4*)(A.mod_h + (size_t)r * 6144 + A.sh_off + 4 * lane + 256 * j); } } }
        f32x4 x[4];
        bf16_t* xb = (XIN == 1 || XOUT == 1) ? (bf16_t*)A.X + (size_t)m * 2048 + 1024 : nullptr;
        if (XIN == 1) {
#pragma unroll
            for (int j = 0; j < 4; ++j) x[j] = unpk4(__builtin_bit_cast(s16x4, cxb[j])); }
        else {
#pragma unroll
            for (int j = 0; j < 4; ++j) x[j] = cxf[j]; }
        if (A.Y) {
            f32x4 y[4]; float ss = 0.f;
#pragma unroll
            for (int j = 0; j < 4; ++j) { y[j] = unpk4(__builtin_bit_cast(s16x4, cy[j]));
                ss += (y[j][0] * y[j][0] + y[j][1] * y[j][1]) + (y[j][2] * y[j][2] + y[j][3] * y[j][3]); }
            const float rstd = rsqrtf(wave_sum(ss) * (1.f / DM) + EPSF);
#pragma unroll
            for (int j = 0; j < 4; ++j) x[j] = x[j] + gtv[j] * (y[j] * rstd * gyv[j]);
        }
        if (XOUT == 1) {
#pragma unroll
            for (int j = 0; j < 4; ++j) { u32x2 o; o.x = pk2(x[j][0], x[j][1]); o.y = pk2(x[j][2], x[j][3]); *(u32x2*)(xb + 4 * lane + 256 * j) = o; } }
        else if (XOUT == 2) {
#pragma unroll
            for (int j = 0; j < 4; ++j) *(f32x4*)(A.X + (size_t)m * DM + 4 * lane + 256 * j) = x[j]; }
        if (A.H) {
            float ss = 0.f;
#pragma unroll
            for (int j = 0; j < 4; ++j) ss += (x[j][0] * x[j][0] + x[j][1] * x[j][1]) + (x[j][2] * x[j][2] + x[j][3] * x[j][3]);
            const float rstd = rsqrtf(wave_sum(ss) * (1.f / DM) + EPSF);
#pragma unroll
            for (int j = 0; j < 4; ++j) { const f32x4 h = (x[j] * rstd * ghv[j]) * (scv[j] + 1.f) + shv[j]; u32x2 o; o.x = pk2(h[0], h[1]); o.y = pk2(h[2], h[3]);
                *(u32x2*)(A.H + (size_t)m * DM + 4 * lane + 256 * j) = o; }
        }
#pragma unroll
        for (int j = 0; j < 4; ++j) { cxf[j] = nxf[j]; cxb[j] = nxb[j]; cy[j] = ny[j]; }
    }
#undef EW_LOADROW
}
__device__ __forceinline__ void gate_phase(const bf16_t* of, int ldf, const bf16_t* ob, int ldb, const bf16_t* z, int ldz, const float* g, bf16_t* out, int gw, int ngw, int lane) {
    const int cg0 = (16 * lane) & 127; float gv[16];
#pragma unroll
    for (int e = 0; e < 16; ++e) gv[e] = g[cg0 + e];
    u32x4 ca[2], cb[2], cc[2], na[2], nb[2], nc[2];
#define GT_LOADROW(mm, av, bv, cv) do { const int m_ = (mm); _Pragma("unroll") for (int hh = 0; hh < 2; ++hh) { av[hh] = *(const u32x4*)(of + (size_t)m_ * ldf + 16 * lane + 8 * hh); \
        bv[hh] = *(const u32x4*)(ob + (size_t)m_ * ldb + 16 * lane + 8 * hh); cv[hh] = *(const u32x4*)(z + (size_t)m_ * ldz + 16 * lane + 8 * hh); } } while (0)
    if (gw < NT) GT_LOADROW(gw, ca, cb, cc);
    for (int m = gw; m < NT; m += ngw) {
        if (m + ngw < NT) GT_LOADROW(m + ngw, na, nb, nc);
        float s[16], zz[16];
#pragma unroll
        for (int hh = 0; hh < 2; ++hh) {
            const u32x4 a = ca[hh], b = cb[hh], c = cc[hh];
#pragma unroll
            for (int e = 0; e < 4; ++e) { s[8 * hh + 2 * e] = bf2f(a[e] & 0xffffu) + bf2f(b[e] & 0xffffu); s[8 * hh + 2 * e + 1] = bf2f(a[e] >> 16) + bf2f(b[e] >> 16);
                zz[8 * hh + 2 * e] = bf2f(c[e] & 0xffffu); zz[8 * hh + 2 * e + 1] = bf2f(c[e] >> 16); }
        }
        float ss = 0.f;
#pragma unroll
        for (int e = 0; e < 16; ++e) ss += s[e] * s[e];
        ss += __int_as_float(__builtin_amdgcn_update_dpp(0, __float_as_int(ss), 0xB1, 0xf, 0xf, false));
        ss += __int_as_float(__builtin_amdgcn_update_dpp(0, __float_as_int(ss), 0x4E, 0xf, 0xf, false));
        ss += __int_as_float(__builtin_amdgcn_update_dpp(0, __float_as_int(ss), 0x141, 0xf, 0xf, false));
        const float rstd = rsqrtf(ss * (1.f / 128.f) + EPSF);
        u32x4 o[2];
#pragma unroll
        for (int hh = 0; hh < 2; ++hh)
#pragma unroll
            for (int e = 0; e < 4; ++e) { const int i0 = 8 * hh + 2 * e; const float v0 = s[i0] * rstd * gv[i0] * zz[i0], v1 = s[i0 + 1] * rstd * gv[i0 + 1] * zz[i0 + 1]; o[hh][e] = pk2(v0, v1); }
        *(u32x4*)(out + (size_t)m * DM + 16 * lane) = o[0]; *(u32x4*)(out + (size_t)m * DM + 16 * lane + 8) = o[1];
#pragma unroll
        for (int hh = 0; hh < 2; ++hh) { ca[hh] = na[hh]; cb[hh] = nb[hh]; cc[hh] = nc[hh]; }
    }
#undef GT_LOADROW
}

__device__ __forceinline__ int scan_item_of(int rnd, int bid, int G) {
    if (G == 256) { if (rnd == 0) return bid; if (rnd == 1 && bid >= 128) return bid + 128; return -1; }
    const int it = bid + rnd * G; return it < 384 ? it : -1;
}

constexpr int G_QS = 0, G_KS = 17408, G_KBG = 34816, G_KTL = 53248, G_VB = 71680, G_NW = 90112, G_QK = 107520, G_CW = 116736, G_LB = 124416, G_LD = 133632, G_TB = 137984, G_OS = G_LB, G_GW = 141824, G_BW = 143872, G_EW = 145920;
__device__ __forceinline__ void conv_phase(LAS unsigned char* lds, CPP P, int bid, int G) {
    int tid_ = threadIdx.x; asm volatile("" : "+v"(tid_)); const int tid = tid_;
    bf16_t* proj = (bf16_t*)(P->ws + WS_BIG);
    LAS float* CW = (LAS float*)(lds + G_CW);
    const int c8 = tid & 15, r = tid >> 4, tlo = 2 * r;
    int hcw = bid & 7;
#define CU_LOADCW(hh) do { for (int i = tid; i < 3 * 5 * 128; i += NTHREADS) { const int sec = i / 640, tap = (i / 128) % 5, cc = i & 127; CW[i] = P->in[10][tap * 3072 + sec * 1024 + (hh) * 128 + cc]; } } while (0)
    CU_LOADCW(hcw);
    u32x4 rq[6], rk[6], rv[6], nq[6], nk[6], nv[6];
#define CU_PBASE(unit) (proj + (size_t)(NPR + ((unit) >> 8) * TS + (((unit) >> 3) & 31) * 64 + tlo) * LD0 + ((unit) & 7) * 128 + c8 * 8)
#define CU_LOAD(unit, q_, k_, v_) do { const bf16_t* pb_ = CU_PBASE(unit); _Pragma("unroll") for (int i = 0; i < 6; ++i) { const int tt = tlo - 2 + i; const bool ok = (tt >= 0 && tt < 64); const bf16_t* pr = pb_ + (ptrdiff_t)(ok ? (i - 2) : 0) * LD0; \
        const u32x4 a = *(const u32x4*)(pr), bb = *(const u32x4*)(pr + 1024), c = *(const u32x4*)(pr + 2048); const u32x4 z = (u32x4){0u, 0u, 0u, 0u}; q_[i] = ok ? a : z; k_[i] = ok ? bb : z; v_[i] = ok ? c : z; } } while (0)
    if (bid < 2048) CU_LOAD(bid, rq, rk, rv);
    for (int unit = bid; unit < 2048; unit += G) {
        const bool has_next = (unit + G < 2048);
        if ((unit & 7) != hcw) { __syncthreads(); hcw = unit & 7; CU_LOADCW(hcw); }
        if (has_next) { CU_LOAD(unit + G, nq, nk, nv); asm volatile("s_waitcnt vmcnt(18) lgkmcnt(0)" ::: "memory"); }
        else asm volatile("s_waitcnt vmcnt(0) lgkmcnt(0)" ::: "memory");
        __builtin_amdgcn_s_barrier(); asm volatile("" ::: "memory");
        bf16_t* pbase = CU_PBASE(unit);
#define CU_CONV(sec, rw, al, ah) do { f32x2 al2[4], ah2[4]; _Pragma("unroll") for (int e = 0; e < 4; ++e) { al2[e] = (f32x2){0.f, 0.f}; ah2[e] = (f32x2){0.f, 0.f}; } \
        _Pragma("unroll") for (int i = 0; i < 6; ++i) { f32x2 x2[4]; \
            _Pragma("unroll") for (int e = 0; e < 4; ++e) { x2[e][0] = __uint_as_float(rw[i][e] << 16); x2[e][1] = __uint_as_float(rw[i][e] & 0xffff0000u); } \
            if (i < 5) { const LAS float* cw = CW + ((sec) * 5 + i) * 128 + c8 * 8; const f32x4 w0 = *(const LAS f32x4*)cw, w1 = *(const LAS f32x4*)(cw + 4); \
                al2[0] += x2[0] * (f32x2){w0[0], w0[1]}; al2[1] += x2[1] * (f32x2){w0[2], w0[3]}; al2[2] += x2[2] * (f32x2){w1[0], w1[1]}; al2[3] += x2[3] * (f32x2){w1[2], w1[3]}; } \
            if (i > 0) { const LAS float* cw = CW + ((sec) * 5 + i - 1) * 128 + c8 * 8; const f32x4 w0 = *(const LAS f32x4*)cw, w1 = *(const LAS f32x4*)(cw + 4); \
                ah2[0] += x2[0] * (f32x2){w0[0], w0[1]}; ah2[1] += x2[1] * (f32x2){w0[2], w0[3]}; ah2[2] += x2[2] * (f32x2){w1[0], w1[1]}; ah2[3] += x2[3] * (f32x2){w1[2], w1[3]}; } } \
        _Pragma("unroll") for (int e = 0; e < 4; ++e) { al[2 * e] = silu_f(al2[e][0]); al[2 * e + 1] = silu_f(al2[e][1]); ah[2 * e] = silu_f(ah2[e][0]); ah[2 * e + 1] = silu_f(ah2[e][1]); } } while (0)
#define CU_STORE(sec, al, ah, rl, rh) do { u32x4 lo4, hi4; _Pragma("unroll") for (int e = 0; e < 4; ++e) { lo4[e] = pk2(al[2 * e] * (rl), al[2 * e + 1] * (rl)); hi4[e] = pk2(ah[2 * e] * (rh), ah[2 * e + 1] * (rh)); } \
        *(u32x4*)(pbase + (sec) * 1024) = lo4; *(u32x4*)(pbase + LD0 + (sec) * 1024) = hi4; } while (0)
    float al[8], ah[8];
#pragma unroll
    for (int sec = 0; sec < 3; ++sec) {
        if (sec == 0) CU_CONV(0, rq, al, ah); else if (sec == 1) CU_CONV(1, rk, al, ah); else CU_CONV(2, rv, al, ah);
        float rl = 1.f, rh = 1.f;
        if (sec < 2) { float sl = 0.f, sh = 0.f;
#pragma unroll
            for (int e = 0; e < 8; ++e) { sl += al[e] * al[e]; sh += ah[e] * ah[e]; }
#pragma unroll
            for (int o = 1; o < 16; o <<= 1) { sl += __shfl_xor(sl, o); sh += __shfl_xor(sh, o); }
            const float scl = (sec == 0) ? 0.08838834764831845f : 1.f; rl = rsqrtf(sl + EPSF) * scl; rh = rsqrtf(sh + EPSF) * scl; }
        CU_STORE(sec, al, ah, rl, rh);
    }
#pragma unroll
        for (int i = 0; i < 6; ++i) { rq[i] = nq[i]; rk[i] = nk[i]; rv[i] = nv[i]; }
    }
#undef CU_CONV
#undef CU_STORE
#undef CU_LOAD
#undef CU_PBASE
#undef CU_LOADCW
    __syncthreads();
}

__device__ __forceinline__ void gdn_item(LAS unsigned char* lds, CPP P, int item) {
    int tid_ = threadIdx.x; asm volatile("" : "+v"(tid_)); const int tid0 = tid_, lane0 = tid0 & 63, wid = __builtin_amdgcn_readfirstlane(tid0 >> 6), fr0 = lane0 & 15, fq0 = lane0 >> 4;
    const bool samp = item < 128; const int p = samp ? item : item - 128;
    const int b = p >> 4, h = (p >> 1) & 7, d = p & 1;
    const int T = samp ? TS : TP, m0 = samp ? NPR + b * TS : b * TP, NC = T / 64;
    const bf16_t* proj = (const bf16_t*)(P->ws + WS_BIG);
    bf16_t* od = (bf16_t*)(P->ws + (d ? WS_210 : WS_170));
    LAS bf16_t* QS = (LAS bf16_t*)(lds + G_QS); LAS bf16_t* KS = (LAS bf16_t*)(lds + G_KS); LAS bf16_t* KBG = (LAS bf16_t*)(lds + G_KBG); LAS bf16_t* KTL = (LAS bf16_t*)(lds + G_KTL);
    LAS bf16_t* VB = (LAS bf16_t*)(lds + G_VB); LAS bf16_t* NW = (LAS bf16_t*)(lds + G_NW); LAS bf16_t* QK = (LAS bf16_t*)(lds + G_QK); LAS bf16_t* LB = (LAS bf16_t*)(lds + G_LB);
    LAS float* LD = (LAS float*)(lds + G_LD); LAS bf16_t* TB = (LAS bf16_t*)(lds + G_TB); LAS float* CW = (LAS float*)(lds + G_CW); LAS bf16_t* OS = (LAS bf16_t*)(lds + G_OS);
    for (int i = tid0; i < 3 * 5 * 128; i += NTHREADS) { const int sec = i / 640, tap = (i / 128) % 5, cc = i & 127; CW[i] = P->in[10][tap * 3072 + sec * 1024 + h * 128 + cc]; }
    const float A_neg = -__expf(P->in[11][d * 8 + h]), dtb = P->in[12][d * 8 + h];
    f32x4 S[8];
    if (samp) { const float* s0 = P->in[2] + ((size_t)(b * 2 + d) * 8 + h) * 16384;
#pragma unroll
        for (int kb = 0; kb < 8; ++kb)
#pragma unroll
            for (int j = 0; j < 4; ++j) S[kb][j] = s0[(16 * kb + 4 * fq0 + j) * 128 + 16 * wid + fr0]; }
    else {
#pragma unroll
        for (int kb = 0; kb < 8; ++kb) S[kb] = (f32x4){0.f, 0.f, 0.f, 0.f}; }
    LAS float* GW = (LAS float*)(lds + G_GW) + wid * 64; LAS float* BW = (LAS float*)(lds + G_BW) + wid * 64; LAS float* EW = (LAS float*)(lds + G_EW) + wid * 64;
    u32x4 rq[6], rk[6], rv[6]; unsigned gbr, gar;
#define TOKN(nn, i) (d ? (T - 1 - (64 * (nn) + (i))) : (64 * (nn) + (i)))
#define GDN_ISSUE(nn, tidx) do { const int c8_ = (tidx) & 15, r_ = (tidx) >> 4; const int tA_ = TOKN(nn, 2 * r_), tB_ = TOKN(nn, 2 * r_ + 1); const int tlo_ = tA_ < tB_ ? tA_ : tB_; \
        const bf16_t* pb_ = proj + (size_t)(m0 + tlo_) * LD0 + h * 128 + c8_ * 8; \
        if (samp) { rq[2] = *(const u32x4*)(pb_); rk[2] = *(const u32x4*)(pb_ + 1024); rv[2] = *(const u32x4*)(pb_ + 2048); rq[3] = *(const u32x4*)(pb_ + LD0); rk[3] = *(const u32x4*)(pb_ + LD0 + 1024); rv[3] = *(const u32x4*)(pb_ + LD0 + 2048); } \
        else { _Pragma("unroll") for (int i = 0; i < 6; ++i) { const int tt = tlo_ - 2 + i; const bool ok = (tt >= 0 && tt < T); const bf16_t* pr_ = pb_ + (ptrdiff_t)(ok ? (i - 2) : 0) * LD0; \
            const u32x4 a_ = *(const u32x4*)(pr_), b_ = *(const u32x4*)(pr_ + 1024), c_ = *(const u32x4*)(pr_ + 2048); const u32x4 z_ = (u32x4){0u, 0u, 0u, 0u}; rq[i] = ok ? a_ : z_; rk[i] = ok ? b_ : z_; rv[i] = ok ? c_ : z_; } } \
        const bf16_t* pg_ = proj + (size_t)(m0 + TOKN(nn, (tidx) & 63)) * LD0 + 4096 + d * 8 + h; gbr = pg_[0]; gar = pg_[16]; } while (0)
    GDN_ISSUE(0, tid0);
    LDS_SYNC();
    for (int n = 0; n < NC; ++n) {
        int tid = tid0; asm volatile("" : "+v"(tid));
        const int lane = tid & 63, fr = lane & 15, fq = lane >> 4;
        float Glast;
        { const float braw = bf2f(gbr), araw = bf2f(gar);
          const float beta_l = sigmoid_f(braw); const float xx = araw + dtb; const float sp = (xx > 20.f) ? xx : log1pf(__expf(xx)); float g = A_neg * sp;
          { int x_;
#define DPPADD(ctrl, rmask) do { x_ = __builtin_amdgcn_update_dpp(0, __float_as_int(g), (ctrl), (rmask), 0xf, false); g += __int_as_float(x_); } while (0)
            DPPADD(0x111, 0xf); DPPADD(0x112, 0xf); DPPADD(0x114, 0xf); DPPADD(0x118, 0xf); DPPADD(0x142, 0xa); DPPADD(0x143, 0xc);
#undef DPPADD
          }
          GW[lane] = g; BW[lane] = beta_l; EW[lane] = __expf(g); Glast = __int_as_float(__builtin_amdgcn_readlane(__float_as_int(g), 63)); }
_Pragma("unroll")
        for (int rep_ = 0; rep_ < (PROBE_GCONV2 ? 2 : 1); ++rep_)
        { const int c8 = tid & 15, r = tid >> 4;
          const int rlo = d ? 2 * r + 1 : 2 * r, rhi = d ? 2 * r : 2 * r + 1;
          const float be_lo = BW[rlo], be_hi = BW[rhi], G_lo = GW[rlo], G_hi = GW[rhi];
          const int tlo_off = 4 * ((rlo >> 2) ^ c8) + (rlo & 3), thi_off = 4 * ((rhi >> 2) ^ c8) + (rhi & 3);
#define GDN_CONV(sec, rw, al, ah) do { f32x2 al2[4], ah2[4]; _Pragma("unroll") for (int e = 0; e < 4; ++e) { al2[e] = (f32x2){0.f, 0.f}; ah2[e] = (f32x2){0.f, 0.f}; } \
              _Pragma("unroll") for (int i = 0; i < 6; ++i) { f32x2 x2[4]; \
                  _Pragma("unroll") for (int e = 0; e < 4; ++e) { x2[e][0] = __uint_as_float(rw[i][e] << 16); x2[e][1] = __uint_as_float(rw[i][e] & 0xffff0000u); } \
                  if (i < 5) { const LAS float* cw = CW + ((sec) * 5 + i) * 128 + c8 * 8; const f32x4 w0 = *(const LAS f32x4*)cw, w1 = *(const LAS f32x4*)(cw + 4); \
                      al2[0] += x2[0] * (f32x2){w0[0], w0[1]}; al2[1] += x2[1] * (f32x2){w0[2], w0[3]}; al2[2] += x2[2] * (f32x2){w1[0], w1[1]}; al2[3] += x2[3] * (f32x2){w1[2], w1[3]}; } \
                  if (i > 0) { const LAS float* cw = CW + ((sec) * 5 + i - 1) * 128 + c8 * 8; const f32x4 w0 = *(const LAS f32x4*)cw, w1 = *(const LAS f32x4*)(cw + 4); \
                      ah2[0] += x2[0] * (f32x2){w0[0], w0[1]}; ah2[1] += x2[1] * (f32x2){w0[2], w0[3]}; ah2[2] += x2[2] * (f32x2){w1[0], w1[1]}; ah2[3] += x2[3] * (f32x2){w1[2], w1[3]}; } } \
              _Pragma("unroll") for (int e = 0; e < 4; ++e) { al[2 * e] = silu_f(al2[e][0]); al[2 * e + 1] = silu_f(al2[e][1]); ah[2 * e] = silu_f(ah2[e][0]); ah[2 * e + 1] = silu_f(ah2[e][1]); } } while (0)
#define GDN_NORM(al, ah, scl, rl, rh) do { float sl = 0.f, sh = 0.f; \
              _Pragma("unroll") for (int e = 0; e < 8; ++e) { sl += al[e] * al[e]; sh += ah[e] * ah[e]; } \
              _Pragma("unroll") for (int o = 1; o < 16; o <<= 1) { sl += __shfl_xor(sl, o); sh += __shfl_xor(sh, o); } \
              rl = rsqrtf(sl + EPSF) * (scl); rh = rsqrtf(sh + EPSF) * (scl); } while (0)
          float al[8], ah[8]; float rl, rh;
          if (samp) {
              *(LAS u32x4*)(QS + rlo * 136 + c8 * 8) = rq[2]; *(LAS u32x4*)(QS + rhi * 136 + c8 * 8) = rq[3];
              *(LAS u32x4*)(KS + rlo * 136 + c8 * 8) = rk[2]; *(LAS u32x4*)(KS + rhi * 136 + c8 * 8) = rk[3];
#pragma unroll
              for (int e = 0; e < 4; ++e) { al[2 * e] = __uint_as_float(rk[2][e] << 16); al[2 * e + 1] = __uint_as_float(rk[2][e] & 0xffff0000u); ah[2 * e] = __uint_as_float(rk[3][e] << 16); ah[2 * e + 1] = __uint_as_float(rk[3][e] & 0xffff0000u); }
              { const float bgl = be_lo * __expf(G_lo), bgh = be_hi * __expf(G_hi), tll = __expf(Glast - G_lo), tlh = __expf(Glast - G_hi);
#pragma unroll
                for (int e = 0; e < 8; ++e) { const int cb = (c8 * 8 + e) * 72;
                    KBG[cb + tlo_off] = (bf16_t)(pk2(al[e] * bgl, 0.f) & 0xffffu); KBG[cb + thi_off] = (bf16_t)(pk2(ah[e] * bgh, 0.f) & 0xffffu);
                    KTL[cb + tlo_off] = (bf16_t)(pk2(al[e] * tll, 0.f) & 0xffffu); KTL[cb + thi_off] = (bf16_t)(pk2(ah[e] * tlh, 0.f) & 0xffffu); } }
#pragma unroll
              for (int e = 0; e < 4; ++e) { al[2 * e] = __uint_as_float(rv[2][e] << 16); al[2 * e + 1] = __uint_as_float(rv[2][e] & 0xffff0000u); ah[2 * e] = __uint_as_float(rv[3][e] << 16); ah[2 * e + 1] = __uint_as_float(rv[3][e] & 0xffff0000u); }
#pragma unroll
              for (int e = 0; e < 8; ++e) { const int cb = (c8 * 8 + e) * 72; VB[cb + tlo_off] = (bf16_t)(pk2(al[e] * be_lo, 0.f) & 0xffffu); VB[cb + thi_off] = (bf16_t)(pk2(ah[e] * be_hi, 0.f) & 0xffffu); }
          } else {
          GDN_CONV(0, rq, al, ah);
          GDN_NORM(al, ah, 0.08838834764831845f, rl, rh);
          { u32x4 lo4, hi4;
#pragma unroll
            for (int e = 0; e < 4; ++e) { lo4[e] = pk2(al[2 * e] * rl, al[2 * e + 1] * rl); hi4[e] = pk2(ah[2 * e] * rh, ah[2 * e + 1] * rh); }
            *(LAS u32x4*)(QS + rlo * 136 + c8 * 8) = lo4; *(LAS u32x4*)(QS + rhi * 136 + c8 * 8) = hi4; }
          GDN_CONV(1, rk, al, ah);
          GDN_NORM(al, ah, 1.f, rl, rh);
          { u32x4 lo4, hi4;
#pragma unroll
            for (int e = 0; e < 4; ++e) { lo4[e] = pk2(al[2 * e] * rl, al[2 * e + 1] * rl); hi4[e] = pk2(ah[2 * e] * rh, ah[2 * e + 1] * rh); }
            *(LAS u32x4*)(KS + rlo * 136 + c8 * 8) = lo4; *(LAS u32x4*)(KS + rhi * 136 + c8 * 8) = hi4;
            const float bgl = rl * be_lo * __expf(G_lo), bgh = rh * be_hi * __expf(G_hi), tll = rl * __expf(Glast - G_lo), tlh = rh * __expf(Glast - G_hi);
#pragma unroll
            for (int e = 0; e < 8; ++e) { const int cb = (c8 * 8 + e) * 72;
                KBG[cb + tlo_off] = (bf16_t)(pk2(al[e] * bgl, 0.f) & 0xffffu); KBG[cb + thi_off] = (bf16_t)(pk2(ah[e] * bgh, 0.f) & 0xffffu);
                KTL[cb + tlo_off] = (bf16_t)(pk2(al[e] * tll, 0.f) & 0xffffu); KTL[cb + thi_off] = (bf16_t)(pk2(ah[e] * tlh, 0.f) & 0xffffu); } }
          GDN_CONV(2, rv, al, ah);
#pragma unroll
          for (int e = 0; e < 8; ++e) { const int cb = (c8 * 8 + e) * 72; VB[cb + tlo_off] = (bf16_t)(pk2(al[e] * be_lo, 0.f) & 0xffffu); VB[cb + thi_off] = (bf16_t)(pk2(ah[e] * be_hi, 0.f) & 0xffffu); }
          }
#undef GDN_CONV
#undef GDN_NORM
        }
        LDS_SYNC();
        f32x4 U[4];
        for (int rep2_ = 0; rep2_ < (PROBE_GSOLVE2 ? 2 : 1); ++rep2_) {
        { const int ntile = (wid < 4) ? 2 : 3;
          for (int tq = 0; tq < ntile; ++tq) {
            int ty, ci, si;
            if (wid < 4 && tq == 0) { ty = 0; ci = wid; si = wid; }
            else { const int k = (wid < 4) ? wid : 4 + 3 * (wid - 4) + tq;
                   if (k < 6) { ty = 0; ci = (k < 1) ? 1 : (k < 3) ? 2 : 3; si = k - (ci * (ci - 1)) / 2; }
                   else { ty = 1; const int idx = k - 6; ci = (idx >= 6) ? 3 : (idx >= 3) ? 2 : (idx >= 1) ? 1 : 0; si = idx - (ci * (ci + 1)) / 2; } }
            const LAS bf16_t* Bsrc = ty ? QS : KS; f32x4 acc = (f32x4){0.f, 0.f, 0.f, 0.f};
#pragma unroll
            for (int ks = 0; ks < 4; ++ks) { const bf16x8 a = *(const LAS bf16x8*)(KS + (16 * si + fr) * 136 + 32 * ks + 8 * fq); const bf16x8 bb = *(const LAS bf16x8*)(Bsrc + (16 * ci + fr) * 136 + 32 * ks + 8 * fq); acc = mfma32(a, bb, acc); }
            const int c = 16 * ci + fr; const float Gc = GW[c], bc = BW[c]; const f32x4 Gs4 = *(const LAS f32x4*)(GW + 16 * si + 4 * fq);
            float val[4];
#pragma unroll
            for (int j = 0; j < 4; ++j) { const int s = 16 * si + 4 * fq + j; const float Gs = Gs4[j];
                if (ty == 0) val[j] = (s < c) ? bc * acc[j] * __expf(Gc - Gs) : 0.f; else val[j] = (s <= c) ? acc[j] * __expf(Gc - Gs) : 0.f; }
            if (ty == 0) { u32x2 o; o.x = pk2(-val[0], -val[1]); o.y = pk2(-val[2], -val[3]); *(LAS u32x2*)(LB + c * 72 + 16 * si + 4 * fq) = o; }
            else { u32x2 o; o.x = pk2(val[0], val[1]); o.y = pk2(val[2], val[3]); *(LAS u32x2*)(QK + c * 72 + 16 * si + 4 * fq) = o; }
            if (wid < 4 && tq == 0) {
#pragma unroll
                for (int j = 0; j < 4; ++j) LD[(wid * 16 + fr) * 17 + 4 * fq + j] = val[j];
                if (lane < 16) { const LAS float* Lp = LD + wid * 16 * 17; float Tc[16];
#pragma unroll
                    for (int r = 0; r < 16; ++r) { float a = (r == lane) ? 1.f : 0.f;
#pragma unroll
                        for (int s = 0; s < r; ++s) a -= Lp[r * 17 + s] * Tc[s];
                        Tc[r] = a; }
#pragma unroll
                    for (int r = 0; r < 16; ++r) TB[(wid * 16 + r) * 20 + lane] = (bf16_t)(pk2(Tc[r], 0.f) & 0xffffu); }
            }
          } }
        LDS_SYNC();
        { s16x4 Td[4];
#pragma unroll
          for (int i = 0; i < 4; ++i) Td[i] = *(const LAS s16x4*)(TB + (i * 16 + fr) * 20 + 4 * fq);
          s16x4 Ln[6];
          Ln[0] = *(const LAS s16x4*)(LB + (16 + fr) * 72 + 4 * fq); Ln[1] = *(const LAS s16x4*)(LB + (32 + fr) * 72 + 4 * fq); Ln[2] = *(const LAS s16x4*)(LB + (32 + fr) * 72 + 16 + 4 * fq);
          Ln[3] = *(const LAS s16x4*)(LB + (48 + fr) * 72 + 4 * fq); Ln[4] = *(const LAS s16x4*)(LB + (48 + fr) * 72 + 16 + 4 * fq); Ln[5] = *(const LAS s16x4*)(LB + (48 + fr) * 72 + 32 + 4 * fq);
          const f32x4 zero = (f32x4){0.f, 0.f, 0.f, 0.f};
          const int swz = 2 * wid + (fr >> 3);
#pragma unroll
          for (int part = 0; part < 2; ++part) { const LAS bf16_t* RB = (part ? KBG : VB) + (16 * wid + fr) * 72;
              const s16x4 B0 = *(const LAS s16x4*)(RB + 4 * ((0 + fq) ^ swz)), B1 = *(const LAS s16x4*)(RB + 4 * ((4 + fq) ^ swz)), B2 = *(const LAS s16x4*)(RB + 4 * ((8 + fq) ^ swz)), B3 = *(const LAS s16x4*)(RB + 4 * ((12 + fq) ^ swz));
              f32x4 X0 = mfma16(Td[0], B0, zero); const s16x4 x0 = pk4(X0);
              f32x4 Y = mfma16(Ln[0], x0, unpk4(B1)); f32x4 X1 = mfma16(Td[1], pk4(Y), zero); const s16x4 x1 = pk4(X1);
              Y = mfma16(Ln[1], x0, unpk4(B2)); Y = mfma16(Ln[2], x1, Y); f32x4 X2 = mfma16(Td[2], pk4(Y), zero); const s16x4 x2 = pk4(X2);
              Y = mfma16(Ln[3], x0, unpk4(B3)); Y = mfma16(Ln[4], x1, Y); Y = mfma16(Ln[5], x2, Y); f32x4 X3 = mfma16(Td[3], pk4(Y), zero);
              if (part == 0) { U[0] = X0; U[1] = X1; U[2] = X2; U[3] = X3; }
              else {
#pragma unroll
                  for (int j = 0; j < 4; ++j) { NW[(4 * fq + j) * 136 + 16 * wid + fr] = (bf16_t)(pk2(-X0[j], 0.f) & 0xffffu); NW[(16 + 4 * fq + j) * 136 + 16 * wid + fr] = (bf16_t)(pk2(-X1[j], 0.f) & 0xffffu);
                      NW[(32 + 4 * fq + j) * 136 + 16 * wid + fr] = (bf16_t)(pk2(-X2[j], 0.f) & 0xffffu); NW[(48 + 4 * fq + j) * 136 + 16 * wid + fr] = (bf16_t)(pk2(-X3[j], 0.f) & 0xffffu); } }
          } }
        LDS_SYNC();
        }
        if (n + 1 < NC) GDN_ISSUE(n + 1, tid);
        { s16x4 Sb[8];
#pragma unroll
          for (int kb = 0; kb < 8; ++kb) Sb[kb] = pk4(S[kb]);
          f32x4 oa[4];
#pragma unroll
          for (int i = 0; i < 4; ++i) { oa[i] = (f32x4){0.f, 0.f, 0.f, 0.f};
#pragma unroll
              for (int kb = 0; kb < 8; ++kb) { const s16x4 a = *(const LAS s16x4*)(NW + (16 * i + fr) * 136 + 16 * kb + 4 * fq); U[i] = mfma16(a, Sb[kb], U[i]);
                  const s16x4 a2 = *(const LAS s16x4*)(QS + (16 * i + fr) * 136 + 16 * kb + 4 * fq); oa[i] = mfma16(a2, Sb[kb], oa[i]); } }
#pragma unroll
          for (int i = 0; i < 4; ++i) oa[i] = oa[i] * *(const LAS f32x4*)(EW + 16 * i + 4 * fq);
          s16x4 vb[4];
#pragma unroll
          for (int i = 0; i < 4; ++i) vb[i] = pk4(U[i]);
#pragma unroll
          for (int i = 0; i < 4; ++i)
#pragma unroll
              for (int si = 0; si <= i; ++si) { const s16x4 a = *(const LAS s16x4*)(QK + (16 * i + fr) * 72 + 16 * si + 4 * fq); oa[i] = mfma16(a, vb[si], oa[i]); }
          const float gl = __expf(Glast);
#pragma unroll
          for (int kb = 0; kb < 8; ++kb) { S[kb] = S[kb] * gl; const int swk = 2 * kb + (fr >> 3);
#pragma unroll
              for (int i = 0; i < 4; ++i) { const s16x4 a = *(const LAS s16x4*)(KTL + (16 * kb + fr) * 72 + 4 * ((4 * i + fq) ^ swk)); S[kb] = mfma16(a, vb[i], S[kb]); } }
#pragma unroll
          for (int i = 0; i < 4; ++i)
#pragma unroll
              for (int j = 0; j < 4; ++j) OS[(16 * i + 4 * fq + j) * 136 + 16 * wid + fr] = (bf16_t)(pk2(oa[i][j], 0.f) & 0xffffu);
        }
        LDS_SYNC();
        { const int row = tid >> 3, seg = tid & 7; const int t = TOKN(n, row);
          const u32x4 v0 = *(const LAS u32x4*)(OS + row * 136 + seg * 16), v1 = *(const LAS u32x4*)(OS + row * 136 + seg * 16 + 8);
          bf16_t* dst = od + (size_t)(m0 + t) * DM + h * 128 + seg * 16; *(u32x4*)dst = v0; *(u32x4*)(dst + 8) = v1; }
    }
#undef GDN_ISSUE
#undef TOKN
    LDS_SYNC();
    if (!samp) { float* so = P->out + OUT_SG + ((size_t)(b * 2 + d) * 8 + h) * 16384;
#pragma unroll
        for (int kb = 0; kb < 8; ++kb)
#pragma unroll
            for (int j = 0; j < 4; ++j) so[(16 * kb + 4 * fq0 + j) * 128 + 16 * wid + fr0] = S[kb][j]; }
}

constexpr int H_QI = 0, H_KO = 17408, H_KT = 34816, H_VT = 53248, H_FL = 71680;
template <bool DUMMY>
__device__ __forceinline__ void hgrn_item(LAS unsigned char* lds, CPP P, int item) {
    int tid_ = threadIdx.x; asm volatile("" : "+v"(tid_)); const int tid = tid_, lane = tid & 63, wid = __builtin_amdgcn_readfirstlane(tid >> 6), fr = lane & 15, fq = lane >> 4;
    const bool samp = item < 128; const int p = samp ? item : item - 128;
    const int b = p >> 4, h = (p >> 1) & 7, d = p & 1;
    const int T = samp ? TS : TP, m0 = samp ? NPR + b * TS : b * TP, NC = T / 64;
    bf16_t* proj = (bf16_t*)(P->ws + WS_BIG);
    LAS bf16_t* QI = (LAS bf16_t*)(lds + H_QI); LAS bf16_t* KO = (LAS bf16_t*)(lds + H_KO); LAS bf16_t* KT = (LAS bf16_t*)(lds + H_KT); LAS bf16_t* VT = (LAS bf16_t*)(lds + H_VT); LAS float* FL = (LAS float*)(lds + H_FL);
    const int c = tid & 127, cc = tid >> 7;
    f32x4 S[8];
    if (samp) { const float* s0 = P->in[3] + ((size_t)(b * 2 + d) * 8 + h) * 16384;
#pragma unroll
        for (int kb = 0; kb < 8; ++kb)
#pragma unroll
            for (int j = 0; j < 4; ++j) S[kb][j] = s0[(16 * kb + 4 * fq + j) * 128 + 16 * wid + fr]; }
    else {
#pragma unroll
        for (int kb = 0; kb < 8; ++kb) S[kb] = (f32x4){0.f, 0.f, 0.f, 0.f}; }
    const size_t colq = (size_t)h * 128, colf = (size_t)1024 + d * 1024 + h * 128, colv = (size_t)3072 + h * 128;
    unsigned pq[16], pf[16], pv[16];
    const int tsgn = d ? -1 : 1;
#define H_T0(nn) (d ? (T - 1 - 64 * (nn)) : 64 * (nn))
#define H_ISSUE(nn) do { const bf16_t* pr0_ = proj + (size_t)(m0 + H_T0(nn)) * LD1 + (ptrdiff_t)(tsgn * 16 * cc) * LD1 + c; const ptrdiff_t st_ = (ptrdiff_t)tsgn * LD1; \
        _Pragma("unroll") for (int ta = 0; ta < 16; ++ta) { const bf16_t* pr_ = pr0_ + ta * st_; pq[ta] = pr_[colq]; pf[ta] = pr_[colf]; pv[ta] = pr_[colv]; } } while (0)
    H_ISSUE(0);
    for (int n = 0; n < NC; ++n) {
        auto tok = [&](int i) -> int { return d ? (T - 1 - (64 * n + i)) : (64 * n + i); };
        { float ko[16]; float ebc = 1.f;
#pragma unroll
          for (int ta = 0; ta < 16; ++ta) { const int i = 16 * cc + ta;
              const float qs = bf2f(pq[ta]), f = bf2f(pf[ta]);
              ebc *= f; ko[ta] = (1.f - f) * __builtin_amdgcn_rcpf(ebc);
              QI[i * 136 + c] = (bf16_t)(pk2(qs * ebc, 0.f) & 0xffffu); KO[i * 136 + c] = (bf16_t)(pk2(ko[ta], 0.f) & 0xffffu); }
          u32x4 k0, k1, v0, v1;
#pragma unroll
          for (int e = 0; e < 4; ++e) { k0[e] = pk2(ko[2 * e] * ebc, ko[2 * e + 1] * ebc); k1[e] = pk2(ko[8 + 2 * e] * ebc, ko[9 + 2 * e] * ebc);
              v0[e] = pv[2 * e] | (pv[2 * e + 1] << 16); v1[e] = pv[8 + 2 * e] | (pv[9 + 2 * e] << 16); }
          *(LAS u32x4*)(KT + c * 72 + 16 * cc) = k0; *(LAS u32x4*)(KT + c * 72 + 16 * cc + 8) = k1; *(LAS u32x4*)(VT + c * 72 + 16 * cc) = v0; *(LAS u32x4*)(VT + c * 72 + 16 * cc + 8) = v1;
          FL[cc * 128 + c] = ebc; }
        LDS_SYNC();
        if (n + 1 < NC) H_ISSUE(n + 1);
#pragma unroll 1
        for (int q4 = 0; q4 < 4; ++q4) {
            f32x4 at = (f32x4){0.f, 0.f, 0.f, 0.f};
#pragma unroll
            for (int ks = 0; ks < 4; ++ks) { const bf16x8 a = *(const LAS bf16x8*)(KO + (16 * q4 + fr) * 136 + 32 * ks + 8 * fq); const bf16x8 bb = *(const LAS bf16x8*)(QI + (16 * q4 + fr) * 136 + 32 * ks + 8 * fq); at = mfma32(a, bb, at); }
#pragma unroll
            for (int j = 0; j < 4; ++j) at[j] = (4 * fq + j <= fr) ? at[j] : 0.f;
            const s16x4 atb = pk4(at);
            f32x4 oa = (f32x4){0.f, 0.f, 0.f, 0.f};
#pragma unroll
            for (int kp = 0; kp < 4; ++kp) { const LAS bf16_t* pa = QI + (16 * q4 + fr) * 136 + 32 * kp + 4 * fq;
                oa = mfma32(__builtin_shufflevector(*(const LAS s16x4*)pa, *(const LAS s16x4*)(pa + 16), 0, 1, 2, 3, 4, 5, 6, 7), __builtin_shufflevector(pk4(S[2 * kp]), pk4(S[2 * kp + 1]), 0, 1, 2, 3, 4, 5, 6, 7), oa); }
            const s16x4 bv = *(const LAS s16x4*)(VT + (16 * wid + fr) * 72 + 16 * q4 + 4 * fq);
            oa = mfma16(atb, bv, oa);
#pragma unroll
            for (int kb = 0; kb < 8; ++kb) { const f32x4 fl = *(const LAS f32x4*)(FL + q4 * 128 + 16 * kb + 4 * fq); S[kb] = S[kb] * fl;
                const s16x4 a = *(const LAS s16x4*)(KT + (16 * kb + fr) * 72 + 16 * q4 + 4 * fq); S[kb] = mfma16(a, bv, S[kb]); }
            { bf16_t* op0 = DUMMY ? (bf16_t*)(P->ws + WS_200) + (size_t)(m0 + H_T0(n) + tsgn * (16 * q4 + 4 * fq)) * DM + h * 128 + 16 * wid + fr : proj + (size_t)(m0 + H_T0(n) + tsgn * (16 * q4 + 4 * fq)) * LD1 + colf + 16 * wid + fr; const ptrdiff_t ost = (ptrdiff_t)tsgn * (DUMMY ? DM : LD1);
#pragma unroll
            for (int j = 0; j < 4; ++j) op0[j * ost] = (bf16_t)(pk2(oa[j], 0.f) & 0xffffu); }
        }
        LDS_SYNC();
    }
    if (!samp) { float* so = P->out + OUT_SH + ((size_t)(b * 2 + d) * 8 + h) * 16384;
#pragma unroll
        for (int kb = 0; kb < 8; ++kb)
#pragma unroll
            for (int j = 0; j < 4; ++j) so[(16 * kb + 4 * fq + j) * 128 + 16 * wid + fr] = S[kb][j]; }
}

#define XB_TMO      128
#define XB_XCNT(j)  (256  + 64 * (j))
#define XB_XSUB(j)  (1280 + 64 * (j))
#define XB_XGEN(j)  (2304 + 64 * (j))
#define XB_TOP      3328
#define XB_TOPGEN   3392
#define XCD_BAR_WORDS 3456
#define XB_SPIN_CAP (1u << 18)

__device__ __forceinline__ unsigned xb_ld(unsigned* p)              { return __hip_atomic_load(p, __ATOMIC_RELAXED, __HIP_MEMORY_SCOPE_AGENT); }
__device__ __forceinline__ unsigned xb_add(unsigned* p, unsigned v) { return __hip_atomic_fetch_add(p, v, __ATOMIC_RELAXED, __HIP_MEMORY_SCOPE_AGENT); }
__device__ __forceinline__ unsigned xb_xcc_id() { return (unsigned)__builtin_amdgcn_s_getreg((3 << 11) | 20) & 0xFu; }
#define XB_SPIN(cond, bar) do { unsigned _sp = 0; while (cond) { __builtin_amdgcn_s_sleep(1); \
    if ((++_sp & 255u) == 0u) { if (xb_ld(&(bar)[XB_TMO])) break; if (_sp > XB_SPIN_CAP) { atomicAdd(&(bar)[XB_TMO], 1u); break; } } } } while (0)

struct XcdBarrier {
    unsigned* bar; unsigned x;
    volatile LAS unsigned* st;
};

__device__ __forceinline__ XcdBarrier xcd_barrier_post(unsigned* bar, volatile LAS unsigned* st) {
    XcdBarrier b; b.bar = bar; b.x = xb_xcc_id(); b.st = st;
    if (threadIdx.x == 0) st[2] = xb_add(&bar[XB_XCNT(b.x)], 1u);
    return b;
}
__device__ __forceinline__ void xcd_barrier_complete(unsigned* bar, unsigned x, unsigned& nloc, unsigned& nx) {
    const unsigned G = gridDim.x * gridDim.y * gridDim.z;
    unsigned sum, cnt, mine, sp = 0u;
    for (;;) {
        sum = 0u; cnt = 0u; mine = 0u;
#pragma unroll
        for (unsigned j = 0; j < 16; ++j) { const unsigned c = xb_ld(&bar[XB_XCNT(j)]); sum += c; cnt += (c > 0u) ? 1u : 0u; mine = (j == x) ? c : mine; }
        if (sum == G) break;
        __builtin_amdgcn_s_sleep(1);
        if ((++sp & 255u) == 0u) { if (xb_ld(&bar[XB_TMO])) break; if (sp > XB_SPIN_CAP) { atomicAdd(&bar[XB_TMO], 1u); break; } }
    }
    nloc = mine > 0u ? mine : 1u; nx = cnt > 0u ? cnt : 1u;
}

__device__ __forceinline__ void xcd_barrier(const XcdBarrier& b) {
    asm volatile("s_waitcnt vmcnt(0)" ::: "memory");
    __syncthreads();
    if (threadIdx.x == 0) {
        unsigned* bar = b.bar;
        __builtin_amdgcn_s_waitcnt(0);
        unsigned nloc = b.st[0], nx = b.st[1];
        if (nloc == 0u) { xcd_barrier_complete(bar, b.x, nloc, nx); b.st[0] = nloc; b.st[1] = nx; }
        const unsigned old = xb_add(&bar[XB_XSUB(b.x)], 1u);
        const unsigned gen = old / nloc;
        if (old + 1u == (gen + 1u) * nloc) {
            __builtin_amdgcn_fence(__ATOMIC_RELEASE, "agent");
            asm volatile("s_waitcnt vmcnt(0)" ::: "memory");
            const unsigned og = xb_add(&bar[XB_TOP], 1u);
            const unsigned tg = og / nx;
            if (og + 1u == (tg + 1u) * nx) xb_add(&bar[XB_TOPGEN], 1u);
            else XB_SPIN(xb_ld(&bar[XB_TOPGEN]) == tg, bar);
            __builtin_amdgcn_fence(__ATOMIC_ACQUIRE, "agent");
            xb_add(&bar[XB_XGEN(b.x)], 1u);
            asm volatile("s_waitcnt vmcnt(0)" ::: "memory");
        } else {
            XB_SPIN(xb_ld(&bar[XB_XGEN(b.x)]) == gen, bar);
            __builtin_amdgcn_fence(__ATOMIC_ACQUIRE, "agent");
            asm volatile("s_waitcnt vmcnt(0)" ::: "memory");
        }
    }
    __syncthreads();
}

template <int ACT>
__device__ __forceinline__ void run_gemm(LAS unsigned char* lds, const bf16_t* A, const bf16_t* Bt, int N, int K, bf16_t* O, int ldc, const float* aux = nullptr) {
    const int vc = (int)((volatile LAS unsigned*)(lds + LDS_BYTES - 16))[3];
    pg8::Gemm g{A, Bt, NT, N, K}; pg8::StaticOrder S; S.init(NT, N, (int)gridDim.x, vc);
    pg8::EpiBf16<ACT> E{O, ldc, aux};
    pg8::gemm_phase<pg8::EpiBf16<ACT>, pg8::StaticOrder, true, true>(lds, g, S, E);
    if (PROBE_GEMM2) { __syncthreads(); pg8::gemm_phase<pg8::EpiBf16<ACT>, pg8::StaticOrder, true, true>(lds, g, S, E); }
}

__global__ void __launch_bounds__(NTHREADS, 2) fwd_megakernel(Params Pval) {
    extern __shared__ __attribute__((aligned(16))) unsigned char lds_raw[];
    LAS unsigned char* lds = (LAS unsigned char*)lds_raw;
    cg::grid_group grid = cg::this_grid();
    CPP Pk = (CPP)__builtin_amdgcn_kernarg_segment_ptr();
    if (threadIdx.x < 4) ((LAS unsigned*)(lds + LDS_BYTES - 16))[threadIdx.x] = 0u;
    __syncthreads();
    const XcdBarrier xbar = xcd_barrier_post((unsigned*)(Pval.ws + WS_BAR), (volatile LAS unsigned*)(lds + LDS_BYTES - 16));
#define PH_BEGIN CPP P = Pk; FRESH(P); int tid_ = threadIdx.x; asm volatile("" : "+v"(tid_)); const int tid = tid_, lane = tid & 63, wave = __builtin_amdgcn_readfirstlane(tid >> 6); const int G = gridDim.x, bid = blockIdx.x, gw = bid * 8 + wave, ngw = G * 8; \
    unsigned char* ws = P->ws; float* X = P->out; float* mod = (float*)(ws + WS_MOD); const float* norm_g = P->in[8]; LAS float* scr = (LAS float*)(lds + 65536 + wave * 8448); \
    (void)lane; (void)gw; (void)ngw; (void)X; (void)mod; (void)norm_g; (void)scr; (void)bid; (void)G;
#define W1_0 ((bf16_t*)(P->out + OUT_SH))
#define W2_0 (W1_0 + (size_t)4096 * 1024)
#define WGIN ((bf16_t*)(ws + WS_170))
#define WOUT0 ((bf16_t*)(ws + WS_WOUT0))
#define WOUT1 ((bf16_t*)(ws + WS_WOUT1))
    { PH_BEGIN
      for (int it = bid; it < 192; it += G) mod_item(P, lds, it);
      convert_matrix(P->in[9], 1024, 4128, WGIN, scr, gw, ngw, lane);
      for (int i = bid * NTHREADS + tid; i < 224 * 1024 / 8; i += G * NTHREADS) *(u32x4*)(WGIN + (size_t)4128 * 1024 + (size_t)i * 8) = (u32x4){0u, 0u, 0u, 0u};
 }
    if (Pval.ws == nullptr) grid.sync();
    xcd_barrier(xbar); if (PROBE_SYNC2) xcd_barrier(xbar);
    { volatile LAS unsigned* ctl = (volatile LAS unsigned*)(lds + LDS_BYTES - 16);
      if (threadIdx.x == 0) { unsigned* bar = (unsigned*)(Pval.ws + WS_BAR); const unsigned Gn = gridDim.x; bool ok = (Gn % 8u) == 0u; unsigned npop = 0u;
#pragma unroll
          for (unsigned j = 0; j < 16; ++j) { const unsigned cnt = xb_ld(&bar[XB_XCNT(j)]); if (j < 8) { ok = ok && (cnt == Gn / 8u); npop += (cnt > 0u) ? 1u : 0u; } else ok = ok && (cnt == 0u); }
          ok = ok && (npop == 8u) && (xbar.x < 8u) && (ctl[2] < Gn / 8u);
          ctl[3] = ok ? (xbar.x + 8u * ctl[2]) : (unsigned)blockIdx.x; }
      __syncthreads(); }
    { PH_BEGIN EwArgs A{P->in[0], P->in[1], nullptr, 0, 0, nullptr, 0, nullptr, nullptr, 0, norm_g + 0 * 1024, mod, 1024, 0, (bf16_t*)(ws + WS_210)}; ew_phase<0, 0>(A, gw, ngw, lane); }
    xcd_barrier(xbar); if (PROBE_SYNC2) xcd_barrier(xbar);
    { PH_BEGIN run_gemm<3>(lds, (const bf16_t*)(ws + WS_210), WGIN, LD0, 1024, (bf16_t*)(ws + WS_BIG), LD0); }
    xcd_barrier(xbar); if (PROBE_SYNC2) xcd_barrier(xbar);
    { PH_BEGIN conv_phase(lds, P, bid, G); }
    xcd_barrier(xbar);
    { PH_BEGIN for (int rnd = 0;; ++rnd) { const int it = scan_item_of(rnd, bid, G); if (it < 0) break; gdn_item(lds, P, it); BLOCK_SYNC(); if (PROBE_GDN2) { gdn_item(lds, P, it); BLOCK_SYNC(); } }
      { const bool half = (G == 256); const int cgw = half ? gw - 128 * 8 : gw, cngw = half ? 128 * 8 : ngw;
        if (cgw >= 0) { convert_matrix(P->in[14], 1024, 1024, WOUT0, scr, cgw, cngw, lane); convert_matrix(P->in[18], 1024, 1024, WOUT1, scr, cgw, cngw, lane);
                        convert_matrix(P->in[19], 1024, 4096, W1_0, scr, cgw, cngw, lane); convert_matrix(P->in[20], 4096, 1024, W2_0, scr, cgw, cngw, lane); } } }
    xcd_barrier(xbar); if (PROBE_SYNC2) xcd_barrier(xbar);
    { PH_BEGIN gate_phase((const bf16_t*)(ws + WS_170), DM, (const bf16_t*)(ws + WS_210), DM, (const bf16_t*)(ws + WS_BIG) + 3072, LD0, P->in[13], (bf16_t*)(ws + WS_170), gw, ngw, lane); }
    xcd_barrier(xbar); if (PROBE_SYNC2) xcd_barrier(xbar);
    { PH_BEGIN run_gemm<0>(lds, (const bf16_t*)(ws + WS_170), WOUT0, 1024, 1024, (bf16_t*)(ws + WS_210), DM); }
    xcd_barrier(xbar); if (PROBE_SYNC2) xcd_barrier(xbar);
    { PH_BEGIN EwArgs A{P->in[0], P->in[1], X, 0, 1, (const bf16_t*)(ws + WS_210), DM, norm_g + 1 * 1024, mod, 2048, norm_g + 2 * 1024, mod, 4096, 3072, (bf16_t*)(ws + WS_170)}; ew_phase<0, 1>(A, gw, ngw, lane); }
    xcd_barrier(xbar); if (PROBE_SYNC2) xcd_barrier(xbar);
    { PH_BEGIN run_gemm<2>(lds, (const bf16_t*)(ws + WS_170), W1_0, 4096, 1024, (bf16_t*)(ws + WS_BIG), 4096); }
    xcd_barrier(xbar); if (PROBE_SYNC2) xcd_barrier(xbar);
    { PH_BEGIN run_gemm<0>(lds, (const bf16_t*)(ws + WS_BIG), W2_0, 1024, 4096, (bf16_t*)(ws + WS_160), DM); }
    xcd_barrier(xbar); if (PROBE_SYNC2) xcd_barrier(xbar);
    { PH_BEGIN EwArgs A{nullptr, nullptr, X, 1, 1, (const bf16_t*)(ws + WS_160), DM, norm_g + 3 * 1024, mod, 5120, norm_g + 4 * 1024, mod + 9 * 6144, 1024, 0, (bf16_t*)(ws + WS_200)}; ew_phase<1, 1>(A, gw, ngw, lane);
      convert_matrix(P->in[15], 1024, 5120, (bf16_t*)(ws + WS_240), scr, gw, ngw, lane); }
    xcd_barrier(xbar); if (PROBE_SYNC2) xcd_barrier(xbar);
    { PH_BEGIN run_gemm<4>(lds, (const bf16_t*)(ws + WS_200), (const bf16_t*)(ws + WS_240), LD1, 1024, (bf16_t*)(ws + WS_BIG), LD1, P->in[16]); }
    xcd_barrier(xbar); if (PROBE_SYNC2) xcd_barrier(xbar);
    { PH_BEGIN for (int rnd = 0;; ++rnd) { const int it = scan_item_of(rnd, bid, G); if (it < 0) break; if (PROBE_HGRN2) { hgrn_item<true>(lds, P, it); BLOCK_SYNC(); } hgrn_item<false>(lds, P, it); BLOCK_SYNC(); } }
    xcd_barrier(xbar); if (PROBE_SYNC2) xcd_barrier(xbar);
    { PH_BEGIN gate_phase((const bf16_t*)(ws + WS_BIG) + 1024, LD1, (const bf16_t*)(ws + WS_BIG) + 2048, LD1, (const bf16_t*)(ws + WS_BIG) + 4096, LD1, P->in[17], (bf16_t*)(ws + WS_200), gw, ngw, lane); }
    xcd_barrier(xbar); if (PROBE_SYNC2) xcd_barrier(xbar);
    { PH_BEGIN run_gemm<0>(lds, (const bf16_t*)(ws + WS_200), WOUT1, 1024, 1024, (bf16_t*)(ws + WS_BIG), DM); }
    xcd_barrier(xbar); if (PROBE_SYNC2) xcd_barrier(xbar);
    { PH_BEGIN EwArgs A{nullptr, nullptr, X, 1, 1, (const bf16_t*)(ws + WS_BIG), DM, norm_g + 5 * 1024, mod + 9 * 6144, 2048, norm_g + 6 * 1024, mod + 9 * 6144, 4096, 3072, (bf16_t*)(ws + WS_200)}; ew_phase<1, 1>(A, gw, ngw, lane);
      convert_matrix(P->in[19] + (size_t)1024 * 4096, 1024, 4096, (bf16_t*)(ws + WS_168), scr, gw, ngw, lane);
      convert_matrix(P->in[20] + (size_t)4096 * 1024, 4096, 1024, (bf16_t*)(ws + WS_160), scr, gw, ngw, lane); }
    xcd_barrier(xbar); if (PROBE_SYNC2) xcd_barrier(xbar);
    { PH_BEGIN run_gemm<2>(lds, (const bf16_t*)(ws + WS_200), (const bf16_t*)(ws + WS_168), 4096, 1024, (bf16_t*)(ws + WS_BIG), 4096); }
    xcd_barrier(xbar); if (PROBE_SYNC2) xcd_barrier(xbar);
    { PH_BEGIN run_gemm<0>(lds, (const bf16_t*)(ws + WS_BIG), (const bf16_t*)(ws + WS_160), 1024, 4096, (bf16_t*)(ws + WS_200), DM); }
    xcd_barrier(xbar); if (PROBE_SYNC2) xcd_barrier(xbar);
    { PH_BEGIN EwArgs A{nullptr, nullptr, X, 1, 0, (const bf16_t*)(ws + WS_200), DM, norm_g + 7 * 1024, mod + 9 * 6144, 5120, nullptr, nullptr, 0, 0, nullptr}; ew_phase<1, 2>(A, gw, ngw, lane); }
}

extern "C" void kernel_launch(void* const* d_in, const int* in_sizes, int n_in, void* d_out, int out_size, void* d_ws, size_t ws_size, hipStream_t stream) {
    static int grid = 0;
    if (grid == 0) {
        if (n_in != 21 || ws_size < WS_NEED) { fprintf(stderr, "kernel_launch: need 21 inputs and >= %zu bytes of workspace (got %d, %zu)\n", (size_t)WS_NEED, n_in, ws_size); grid = -1; return; }
        int dev = 0, cus = 0, per_cu = 0;
        hipGetDevice(&dev); hipDeviceGetAttribute(&cus, hipDeviceAttributeMultiprocessorCount, dev);
        hipFuncSetAttribute((const void*)fwd_megakernel, hipFuncAttributeMaxDynamicSharedMemorySize, LDS_BYTES);
        hipOccupancyMaxActiveBlocksPerMultiprocessor(&per_cu, (const void*)fwd_megakernel, NTHREADS, LDS_BYTES);
        if (per_cu < 1) { fprintf(stderr, "kernel_launch: occupancy query reports %d blocks per CU\n", per_cu); per_cu = 1; }
        grid = cus * 1;
        (void)hipGetLastError();
    }
    if (grid < 0) return;
    Params p{};
    for (int i = 0; i < 21; ++i) p.in[i] = (const float*)d_in[i];
    p.out = (float*)d_out; p.ws = (unsigned char*)d_ws;
    if (hipMemsetAsync((char*)d_ws + WS_BAR, 0, BAR_BYTES, stream) != hipSuccess) { fprintf(stderr, "kernel_launch: memset of barrier words failed\n"); return; }
    void* args[] = {&p};
    hipError_t e = hipLaunchCooperativeKernel((const void*)fwd_megakernel, dim3(grid), dim3(NTHREADS), args, LDS_BYTES, stream);
    if (e != hipSuccess) fprintf(stderr, "cooperative launch failed: %s (grid %d)\n", hipGetErrorString(e), grid);
}
```

```cpp
#include <hip/hip_runtime.h>
#include <hip/hip_cooperative_groups.h>
#include <cstdio>
#include <cstdint>
namespace cg = cooperative_groups;
#ifndef PROBE_GEMM2
#define PROBE_GEMM2 0
#endif
#ifndef PROBE_GDN2
#define PROBE_GDN2 0
#endif
#ifndef PROBE_HGRN2
#define PROBE_HGRN2 0
#endif
#ifndef PROBE_GCONV2
#define PROBE_GCONV2 0
#endif
#ifndef PROBE_GSOLVE2
#define PROBE_GSOLVE2 0
#endif
#ifndef PROBE_SYNC2
#define PROBE_SYNC2 0
#endif
namespace pg8 {
#define PG8_LAS __attribute__((address_space(3)))
typedef unsigned short bf16_t;
typedef short bf16x8 __attribute__((ext_vector_type(8)));
typedef float f32x4 __attribute__((ext_vector_type(4)));
typedef unsigned u32x4 __attribute__((ext_vector_type(4)));
constexpr int BM = 256, BK = 64, HALF = 128, HTB = HALF * BK * 2  , STAGE_BYTES = 8 * HTB, NXCD = 8, WGM = 8;

__host__ __device__ __forceinline__ int lds_byte(int r, int c) { const int st = (r >> 4) * 2 + (c >> 5), rr = r & 15, cc = c & 31, ob = rr * 64 + cc * 2; return st * 1024 + (ob ^ (((ob >> 9) & 1) << 5)); }
__host__ __device__ __forceinline__ void stage_rc(int b, int& R, int& C) { const int st = b / 1024, sb = b % 1024, swz = sb ^ (((sb >> 9) & 1) << 5); R = (st >> 1) * 16 + swz / 64; C = (st & 1) * 32 + (swz % 64) / 2; }
__host__ __device__ __forceinline__ int perm32(int rho) { const int n = rho >> 4, i = rho & 15; return 8 * (i >> 2) + 4 * n + (i & 3); }

struct Unit { int pm, pn; };
struct Gemm { const bf16_t* A; const bf16_t* Bt; int M, N, K; };

struct StaticOrder {
    int nM, nN, nwg, G, c;
    __host__ __device__ void init(int M, int N, int G_, int c_) { nM = M / BM; nN = N / BM; nwg = nM * nN; G = G_; c = c_; }
    __host__ __device__ bool next(int i, Unit& u) const {
        const long L = (long)i * G + c; if (L >= nwg) return false;
        int wgid = (int)L; { const int q = nwg / NXCD, r = nwg % NXCD, xcd = wgid % NXCD, off = wgid / NXCD; wgid = (xcd < r ? xcd * (q + 1) : r * (q + 1) + (xcd - r) * q) + off; }
        if (nN == 4) { u.pm = wgid >> 2; u.pn = wgid & 3; return true; }
        const int nig = WGM * nN, gid = wgid / nig, fm = gid * WGM, gsz = (nM - fm) < WGM ? (nM - fm) : WGM;
        u.pm = fm + ((wgid % nig) % gsz); u.pn = (wgid % nig) / gsz; return true;
    }
    __device__ __forceinline__ void a_ready(const Unit&) const {}
    __device__ __forceinline__ void done(const Unit&) const {}
};

typedef __bf16 b16x2v __attribute__((ext_vector_type(2)));
typedef float f32x2 __attribute__((ext_vector_type(2)));
__device__ __forceinline__ unsigned cvt_pk_bf16(float lo, float hi) { f32x2 v = {lo, hi}; b16x2v r = __builtin_convertvector(v, b16x2v); return __builtin_bit_cast(unsigned, r); }
template <int ACT  > struct EpiBf16 {
    static constexpr bool PERM = true, AFTER_DRAIN = false;
    bf16_t* O; int ldc; const float* aux;
    __device__ __forceinline__ static float silu1(float x) { return x * __builtin_amdgcn_rcpf(1.f + __expf(-x)); }
    __device__ __forceinline__ void operator()(const f32x4 (&acc)[2][2][4][2], const Unit& u, int wr, int wc, int fr, int fq) const {
        const int row0 = u.pm * BM + wr * 64 + fr; const int col0 = u.pn * BM + wc * 32 + 8 * fq;
        const bool do_silu = (ACT == 3) ? (u.pn >= 12 && u.pn < 16) : (ACT == 4) ? (u.pn < 4 || u.pn >= 16) : false;
        const bool do_logf = (ACT == 4) && (u.pn >= 4 && u.pn < 12);
        float lb[2][8];
        if (ACT == 4) { if (do_logf) {
#pragma unroll
            for (int bj = 0; bj < 2; ++bj)
#pragma unroll
                for (int e = 0; e < 8; ++e) { const int k = col0 + bj * HALF + e - 1024; lb[bj][e] = __builtin_amdgcn_rcpf(1.f + __expf(aux[k] - aux[2048 + k])); } } }
#pragma unroll
        for (int ai = 0; ai < 2; ++ai)
#pragma unroll
            for (int m = 0; m < 4; ++m) { bf16_t* rowp = O + (size_t)(row0 + ai * HALF + m * 16) * ldc + col0;
#pragma unroll
                for (int bj = 0; bj < 2; ++bj) { f32x4 v0 = acc[ai][bj][m][0], v1 = acc[ai][bj][m][1];
                    if (ACT == 2) {
#pragma unroll
                        for (int e = 0; e < 4; ++e) { const float a = v0[e] > 0.f ? v0[e] : 0.f, b = v1[e] > 0.f ? v1[e] : 0.f; v0[e] = a * a; v1[e] = b * b; } }
                    if (ACT == 3 || ACT == 4) { if (do_silu) {
#pragma unroll
                        for (int e = 0; e < 4; ++e) { v0[e] = silu1(v0[e]); v1[e] = silu1(v1[e]); } } }
                    if (ACT == 4) { if (do_logf) {
#pragma unroll
                        for (int e = 0; e < 4; ++e) { const float l0 = lb[bj][e], l1 = lb[bj][4 + e];
                            v0[e] = l0 + (1.f - l0) * __builtin_amdgcn_rcpf(1.f + __expf(-v0[e])); v1[e] = l1 + (1.f - l1) * __builtin_amdgcn_rcpf(1.f + __expf(-v1[e])); } } }
                    u32x4 w; w.x = cvt_pk_bf16(v0[0], v0[1]); w.y = cvt_pk_bf16(v0[2], v0[3]); w.z = cvt_pk_bf16(v1[0], v1[1]); w.w = cvt_pk_bf16(v1[2], v1[3]);
                    *(u32x4*)(rowp + bj * HALF) = w; } }
    }
};

template <class Epi, class Sched, bool ALIGN_EPI = false, bool SP2 = false>
__device__ __forceinline__ void gemm_phase(PG8_LAS unsigned char* lds, const Gemm g, const Sched& S, const Epi& E) {
    int tid_ = threadIdx.x; asm volatile("" : "+v"(tid_));
    const int tid = tid_, wid = __builtin_amdgcn_readfirstlane(tid >> 6), lane = tid & 63, wr = wid >> 2, wc = wid & 3, fr = lane & 15, fq = lane >> 4;
    const int K = g.K, nt = K / BK;
    unsigned voffA[2], voffB[2];
#pragma unroll
    for (int i = 0; i < 2; ++i) { int R, C; stage_rc(tid * 16 + i * 8192, R, C); const int Rb = Epi::PERM ? ((R & ~31) + perm32(R & 31)) : R;
        voffA[i] = (unsigned)(R * K + C) * 2u; voffB[i] = (unsigned)(Rb * K + C) * 2u; }
    const size_t kstep = (size_t)(BK * 2);
    const size_t hstep = (size_t)HALF * K * 2;
    const size_t tstep = 2 * hstep;
    const unsigned ldsw = (unsigned)wid * 1024u;
    const int aoff = lds_byte(wr * 64 + fr, fq * 8), boff = lds_byte(wc * 32 + fr, fq * 8);
#define PG8_SA(b, h) (((b) * 2 + (h)) * HTB)
#define PG8_SB(b, h) ((4 + (b) * 2 + (h)) * HTB)
#define PG8_STAGE(bufoff, gbase, voff) do { _Pragma("unroll") for (int _i = 0; _i < 2; ++_i) \
        __builtin_amdgcn_global_load_lds((const unsigned*)((const char*)(gbase) + (voff)[_i]), (PG8_LAS unsigned*)(lds + (bufoff) + ldsw + _i * 8192), 16, 0, 0); } while (0)
#define PG8_LDA(dst, b, h) do { _Pragma("unroll") for (int m = 0; m < 4; ++m) _Pragma("unroll") for (int k = 0; k < 2; ++k) dst[m][k] = *(const PG8_LAS bf16x8*)(lds + PG8_SA(b, h) + aoff + m * 2048 + k * 1024); } while (0)
#define PG8_LDB(dst, b, h) do { _Pragma("unroll") for (int n = 0; n < 2; ++n) _Pragma("unroll") for (int k = 0; k < 2; ++k) dst[n][k] = *(const PG8_LAS bf16x8*)(lds + PG8_SB(b, h) + boff + n * 2048 + k * 1024); } while (0)
#define PG8_MMA(ai, bj, At, Bt) do { __builtin_amdgcn_s_setprio(1); _Pragma("unroll") for (int m = 0; m < 4; ++m) _Pragma("unroll") for (int n = 0; n < 2; ++n) _Pragma("unroll") for (int k = 0; k < 2; ++k) \
        acc[ai][bj][m][n] = __builtin_amdgcn_mfma_f32_16x16x32_bf16(Bt[n][k], At[m][k], acc[ai][bj][m][n], 0, 0, 0); __builtin_amdgcn_s_setprio(0); } while (0)
#define PG8_WAIT_V(n) asm volatile("s_waitcnt vmcnt(" #n ")" ::: "memory")
#define PG8_WAIT_L(n) asm volatile("s_waitcnt lgkmcnt(" #n ")" ::: "memory")
#define PG8_BAR __builtin_amdgcn_s_barrier()
#define PG8_SCHED __builtin_amdgcn_sched_barrier(0)
    Unit cur, nxt; int ui = 0;
    if (!S.next(0, cur)) return;
    f32x4 acc[2][2][4][2];
#pragma unroll
    for (int a = 0; a < 2; ++a)
#pragma unroll
        for (int b = 0; b < 2; ++b)
#pragma unroll
            for (int m = 0; m < 4; ++m)
#pragma unroll
                for (int n = 0; n < 2; ++n) acc[a][b][m][n] = (f32x4){0.f, 0.f, 0.f, 0.f};
    bf16x8 At[4][2], B0[2][2], B1[2][2];
    const char* cA = (const char*)g.A + (size_t)cur.pm * tstep; const char* cB = (const char*)g.Bt + (size_t)cur.pn * tstep;
    S.a_ready(cur);
    if constexpr (SP2) {
        PG8_STAGE(PG8_SB(0, 0), cB, voffB); PG8_STAGE(PG8_SB(0, 1), cB + hstep, voffB); PG8_STAGE(PG8_SA(0, 0), cA, voffA); PG8_STAGE(PG8_SA(0, 1), cA + hstep, voffA);
        if (wr == 1) PG8_BAR;
        PG8_WAIT_V(2); PG8_BAR;
        PG8_STAGE(PG8_SB(1, 0), cB + kstep, voffB); PG8_STAGE(PG8_SA(1, 0), cA + kstep, voffA); PG8_STAGE(PG8_SB(1, 1), cB + hstep + kstep, voffB);
        PG8_WAIT_V(6); PG8_BAR;
    } else {
        PG8_STAGE(PG8_SB(0, 0), cB, voffB); PG8_STAGE(PG8_SA(0, 0), cA, voffA); PG8_STAGE(PG8_SB(0, 1), cB + hstep, voffB); PG8_STAGE(PG8_SA(0, 1), cA + hstep, voffA);
        if (wr == 1) PG8_BAR;
        PG8_WAIT_V(4); PG8_BAR;
        PG8_STAGE(PG8_SB(1, 0), cB + kstep, voffB); PG8_STAGE(PG8_SA(1, 0), cA + kstep, voffA); PG8_STAGE(PG8_SB(1, 1), cB + hstep + kstep, voffB);
        PG8_WAIT_V(6); PG8_BAR;
    }
    for (;;) {
        const bool has_next = S.next(ui + 1, nxt);
        const char* nA = has_next ? (const char*)g.A + (size_t)nxt.pm * tstep : cA; const char* nB = has_next ? (const char*)g.Bt + (size_t)nxt.pn * tstep : cB;
        for (int t = 0; t < nt; t += 2) {
            const bool last = (t == nt - 2);
            const char* a1 = cA + (size_t)(t + 1) * kstep;
            const char* a2 = last ? nA : cA + (size_t)(t + 2) * kstep; const char* b2 = last ? nB : cB + (size_t)(t + 2) * kstep;
            const char* a3 = a2 + kstep; const char* b3 = b2 + kstep;
            if (last && has_next) S.a_ready(nxt);
            if constexpr (SP2) {
            PG8_LDB(B0, 0, 0); PG8_LDB(B1, 0, 1); PG8_SCHED; PG8_LDA(At, 0, 0); PG8_STAGE(PG8_SA(1, 1), a1 + hstep, voffA);
            PG8_WAIT_V(8); PG8_WAIT_L(0); PG8_BAR; PG8_MMA(0, 0, At, B0); PG8_MMA(0, 1, At, B1); PG8_BAR; PG8_SCHED;
            PG8_LDA(At, 0, 1); PG8_STAGE(PG8_SB(0, 0), b2, voffB); PG8_STAGE(PG8_SB(0, 1), b2 + hstep, voffB); PG8_STAGE(PG8_SA(0, 0), a2, voffA);
            PG8_WAIT_V(8); PG8_WAIT_L(0); PG8_BAR; PG8_MMA(1, 0, At, B0); PG8_MMA(1, 1, At, B1); PG8_BAR; PG8_SCHED;
            PG8_LDB(B0, 1, 0); PG8_LDB(B1, 1, 1); PG8_SCHED; PG8_LDA(At, 1, 0); PG8_STAGE(PG8_SA(0, 1), a2 + hstep, voffA);
            PG8_WAIT_V(8); PG8_WAIT_L(0); PG8_BAR; PG8_MMA(0, 0, At, B0); PG8_MMA(0, 1, At, B1); PG8_BAR; PG8_SCHED;
            PG8_LDA(At, 1, 1); PG8_STAGE(PG8_SB(1, 0), b3, voffB); PG8_STAGE(PG8_SB(1, 1), b3 + hstep, voffB); PG8_STAGE(PG8_SA(1, 0), a3, voffA);
            PG8_WAIT_V(8); PG8_WAIT_L(0); PG8_BAR; PG8_MMA(1, 0, At, B0); PG8_MMA(1, 1, At, B1); PG8_BAR; PG8_SCHED;
            } else {
            PG8_LDB(B0, 0, 0); PG8_SCHED; PG8_LDA(At, 0, 0); PG8_STAGE(PG8_SA(1, 1), a1 + hstep, voffA);
            PG8_WAIT_L(8); PG8_BAR; PG8_WAIT_L(0); PG8_MMA(0, 0, At, B0); PG8_BAR; PG8_SCHED;
            PG8_LDB(B1, 0, 1); PG8_STAGE(PG8_SB(0, 0), b2, voffB);
            PG8_BAR; PG8_WAIT_L(0); PG8_MMA(0, 1, At, B1); PG8_BAR;
            PG8_LDA(At, 0, 1); PG8_STAGE(PG8_SA(0, 0), a2, voffA);
            PG8_BAR; PG8_WAIT_L(0); PG8_MMA(1, 0, At, B0); PG8_BAR; PG8_SCHED;
            PG8_STAGE(PG8_SB(0, 1), b2 + hstep, voffB);
            PG8_WAIT_V(6); PG8_BAR; PG8_MMA(1, 1, At, B1); PG8_BAR;
            PG8_LDB(B0, 1, 0); PG8_SCHED; PG8_LDA(At, 1, 0); PG8_STAGE(PG8_SA(0, 1), a2 + hstep, voffA);
            PG8_WAIT_L(8); PG8_BAR; PG8_WAIT_L(0); PG8_MMA(0, 0, At, B0); PG8_BAR; PG8_SCHED;
            PG8_LDB(B1, 1, 1); PG8_STAGE(PG8_SB(1, 0), b3, voffB);
            PG8_BAR; PG8_WAIT_L(0); PG8_MMA(0, 1, At, B1); PG8_BAR;
            PG8_LDA(At, 1, 1); PG8_STAGE(PG8_SA(1, 0), a3, voffA);
            PG8_BAR; PG8_WAIT_L(0); PG8_MMA(1, 0, At, B0); PG8_BAR; PG8_SCHED;
            PG8_STAGE(PG8_SB(1, 1), b3 + hstep, voffB);
            PG8_WAIT_V(6); PG8_BAR; PG8_MMA(1, 1, At, B1); PG8_BAR;
            }
        }
        if constexpr (ALIGN_EPI) { if (wr == 0) PG8_BAR; }
        if constexpr (!Epi::AFTER_DRAIN) { E(acc, cur, wr, wc, fr, fq); S.done(cur); }
        if (!has_next) break;
#pragma unroll
        for (int a = 0; a < 2; ++a)
#pragma unroll
            for (int b = 0; b < 2; ++b)
#pragma unroll
                for (int m = 0; m < 4; ++m)
#pragma unroll
                    for (int n = 0; n < 2; ++n) acc[a][b][m][n] = (f32x4){0.f, 0.f, 0.f, 0.f};
        cur = nxt; cA = nA; cB = nB; ++ui;
        if constexpr (ALIGN_EPI) { if (wr == 1) PG8_BAR; }
    }
    PG8_WAIT_V(0);
    if constexpr (!ALIGN_EPI) { if (wr == 0) PG8_BAR; }
    PG8_BAR;
    if constexpr (Epi::AFTER_DRAIN) { E.fused(acc, cur, wr, wc, fr, fq, lds, wid, lane); S.done(cur); }
#undef PG8_SA
#undef PG8_SB
#undef PG8_STAGE
#undef PG8_LDA
#undef PG8_LDB
#undef PG8_MMA
#undef PG8_WAIT_V
#undef PG8_WAIT_L
#undef PG8_BAR
#undef PG8_SCHED
}
}
#define LAS __attribute__((address_space(3)))
typedef unsigned short bf16_t;
typedef float f32x4 __attribute__((ext_vector_type(4)));
typedef float f32x2 __attribute__((ext_vector_type(2)));
typedef short s16x4 __attribute__((ext_vector_type(4)));
typedef short bf16x8 __attribute__((ext_vector_type(8)));
typedef unsigned u32x4 __attribute__((ext_vector_type(4)));
typedef unsigned u32x2 __attribute__((ext_vector_type(2)));
typedef __bf16 b16x2 __attribute__((ext_vector_type(2)));

constexpr int NT = 20480, NPR = 4096, DM = 1024, TS = 2048, TP = 256;
constexpr int LDS_BYTES = 151552;
constexpr int NTHREADS = 512;
constexpr size_t MiB = (size_t)1 << 20;
constexpr int LD0 = 4352, LD1 = 5120;
constexpr size_t WS_BIG = 0, WS_160 = 160 * MiB, WS_168 = 168 * MiB, WS_170 = 170 * MiB, WS_200 = 200 * MiB, WS_210 = 210 * MiB, WS_240 = 240 * MiB;
constexpr size_t WS_BAR = 255 * MiB, BAR_BYTES = 16384;
constexpr size_t WS_WOUT0 = 250 * MiB, WS_WOUT1 = 252 * MiB, WS_MOD = 254 * MiB, WS_NEED = 256 * MiB;
constexpr size_t OUT_SG = (size_t)NT * DM, OUT_SH = OUT_SG + (size_t)16 * 2 * 8 * 128 * 128;
constexpr float EPSF = 1e-6f;

struct Params { const float* in[21]; float* out; unsigned char* ws; };
typedef const __attribute__((address_space(4))) Params* CPP;
#define FRESH(q) asm volatile("" : "+s"(q))

__device__ __forceinline__ float bf2f(unsigned v) { return __uint_as_float(v << 16); }
__device__ __forceinline__ unsigned pk2(float lo, float hi) { f32x2 v = {lo, hi}; b16x2 r = __builtin_convertvector(v, b16x2); return __builtin_bit_cast(unsigned, r); }
__device__ __forceinline__ s16x4 pk4(f32x4 v) { u32x2 r; r.x = pk2(v[0], v[1]); r.y = pk2(v[2], v[3]); return __builtin_bit_cast(s16x4, r); }
__device__ __forceinline__ f32x4 unpk4(s16x4 v) { u32x2 r = __builtin_bit_cast(u32x2, v); f32x4 o; o[0] = __uint_as_float(r.x << 16); o[1] = __uint_as_float(r.x & 0xffff0000u); o[2] = __uint_as_float(r.y << 16); o[3] = __uint_as_float(r.y & 0xffff0000u); return o; }
__device__ __forceinline__ float silu_f(float x) { return x * __builtin_amdgcn_rcpf(1.f + __expf(-x)); }
__device__ __forceinline__ float sigmoid_f(float x) { return __builtin_amdgcn_rcpf(1.f + __expf(-x)); }
__device__ __forceinline__ f32x4 mfma16(s16x4 a, s16x4 b, f32x4 c) { return __builtin_amdgcn_mfma_f32_16x16x16bf16_1k(a, b, c, 0, 0, 0); }
__device__ __forceinline__ f32x4 mfma32(bf16x8 a, bf16x8 b, f32x4 c) { return __builtin_amdgcn_mfma_f32_16x16x32_bf16(a, b, c, 0, 0, 0); }
#define BLOCK_SYNC() __syncthreads()
#define LDS_SYNC() do { asm volatile("s_waitcnt lgkmcnt(0)" ::: "memory"); __builtin_amdgcn_s_barrier(); asm volatile("" ::: "memory"); } while (0)

__device__ __forceinline__ void transpose_item(const float* W, int K, int N, bf16_t* WT, LAS float* scr, int item, int lane) {
    const int nblk = N / 32, kb = item / nblk, nb = item % nblk, k0 = 64 * kb, n0 = 32 * nb;
#pragma unroll 8
    for (int i = 0; i < 32; ++i) { const int kk = 2 * i + (lane >> 5); scr[kk * 33 + (lane & 31)] = W[(size_t)(k0 + kk) * N + n0 + (lane & 31)]; }
    asm volatile("s_waitcnt lgkmcnt(0)" ::: "memory");
    const int c = lane & 7;
#pragma unroll
    for (int j = 0; j < 4; ++j) { const int n = (lane >> 3) + 8 * j; const LAS float* s = scr + (8 * c) * 33 + n;
        u32x4 o; o.x = pk2(s[0 * 33], s[1 * 33]); o.y = pk2(s[2 * 33], s[3 * 33]); o.z = pk2(s[4 * 33], s[5 * 33]); o.w = pk2(s[6 * 33], s[7 * 33]);
        *(u32x4*)(WT + (size_t)(n0 + n) * K + k0 + 8 * c) = o; }
    asm volatile("s_waitcnt lgkmcnt(0)" ::: "memory");
}
__device__ __forceinline__ void convert_matrix(const float* W, int K, int N, bf16_t* WT, LAS float* scr, int gw, int ngw, int lane) {
    const int nitems = (K / 64) * (N / 32);
    for (int it = gw; it < nitems; it += ngw) transpose_item(W, K, N, WT, scr, it, lane);
}

__device__ __forceinline__ void mod_item(CPP P, LAS unsigned char* lds, int item) {
    int tid_ = threadIdx.x; asm volatile("" : "+v"(tid_)); const int tid = tid_, lane = tid & 63, w = tid >> 6;
    const int layer = item / 96, cb = item % 96, n0 = cb * 64;
    LAS float* ca = (LAS float*)lds;
    LAS float* red = (LAS float*)(lds + 36864);
    const float* c = P->in[4]; const float* cctx = P->in[5];
    for (int i = tid; i < 9 * 1024; i += NTHREADS) { const float v = (i < 1024) ? cctx[i] : c[i - 1024]; ca[i] = silu_f(v); }
    BLOCK_SYNC();
    const float* wp = P->in[6] + (size_t)layer * 1024 * 6144 + n0 + lane;
    float acc[9];
#pragma unroll
    for (int r = 0; r < 9; ++r) acc[r] = 0.f;
#pragma unroll 8
    for (int k = 128 * w; k < 128 * w + 128; ++k) { const float wv = wp[(size_t)k * 6144];
#pragma unroll
        for (int r = 0; r < 9; ++r) acc[r] += ca[r * 1024 + k] * wv; }
#pragma unroll
    for (int r = 0; r < 9; ++r) red[(w * 9 + r) * 64 + lane] = acc[r];
    BLOCK_SYNC();
    float* mod = (float*)(P->ws + WS_MOD);
    for (int idx = tid; idx < 9 * 64; idx += NTHREADS) { const int r = idx >> 6, l = idx & 63; float s = 0.f;
#pragma unroll
        for (int ww = 0; ww < 8; ++ww) s += red[(ww * 9 + r) * 64 + l];
        mod[(size_t)(layer * 9 + r) * 6144 + n0 + l] = s + P->in[7][layer * 6144 + n0 + l]; }
    BLOCK_SYNC();
}

struct EwArgs { const float* xin_p; const float* xin_s; float* X; int xb_in, xb_out;
                const bf16_t* Y; int ldy; const float* gy; const float* mod_y; int gate_off;
                const float* gh; const float* mod_h; int sc_off, sh_off; bf16_t* H; };
__device__ __forceinline__ float wave_sum(float v) {
    int x_;
#define DPPADD(ctrl, rmask) do { x_ = __builtin_amdgcn_update_dpp(0, __float_as_int(v), (ctrl), (rmask), 0xf, false); v += __int_as_float(x_); } while (0)
    DPPADD(0x111, 0xf); DPPADD(0x112, 0xf); DPPADD(0x114, 0xf); DPPADD(0x118, 0xf); DPPADD(0x142, 0xa); DPPADD(0x143, 0xc);
#undef DPPADD
    return __int_as_float(__builtin_amdgcn_readlane(__float_as_int(v), 63));
}
template <int XIN  , int XOUT  >
__device__ __forceinline__ void ew_phase(const EwArgs& A, int gw, int ngw, int lane) {
    const int per = (NT + ngw - 1) / ngw; const int mbeg = gw * per, mend = (mbeg + per < NT) ? mbeg + per : NT;
    f32x4 gyv[4], ghv[4], gtv[4], scv[4], shv[4];
#pragma unroll
    for (int j = 0; j < 4; ++j) { gyv[j] = A.Y ? *(const f32x4*)(A.gy + 4 * lane + 256 * j) : (f32x4){0.f, 0.f, 0.f, 0.f}; ghv[j] = A.H ? *(const f32x4*)(A.gh + 4 * lane + 256 * j) : (f32x4){0.f, 0.f, 0.f, 0.f};
        gtv[j] = (f32x4){0.f, 0.f, 0.f, 0.f}; scv[j] = gtv[j]; shv[j] = gtv[j]; }
    f32x4 cxf[4], nxf[4]; u32x2 cxb[4], nxb[4], cy[4], ny[4];
#define EW_LOADROW(mm, xf, xbv, yv) do { const int m_ = (mm); \
        if (XIN == 1) { const bf16_t* xb_ = (const bf16_t*)A.X + (size_t)m_ * 2048 + 1024; _Pragma("unroll") for (int j = 0; j < 4; ++j) xbv[j] = *(const u32x2*)(xb_ + 4 * lane + 256 * j); } \
        else { const float* xr_ = (m_ < NPR) ? A.xin_p + (size_t)m_ * DM : A.xin_s + (size_t)(m_ - NPR) * DM; _Pragma("unroll") for (int j = 0; j < 4; ++j) xf[j] = *(const f32x4*)(xr_ + 4 * lane + 256 * j); } \
        if (A.Y) { _Pragma("unroll") for (int j = 0; j < 4; ++j) yv[j] = *(const u32x2*)(A.Y + (size_t)m_ * A.ldy + 4 * lane + 256 * j); } } while (0)
    if (mbeg < mend) EW_LOADROW(mbeg, cxf, cxb, cy);
    int rcur = -1;
    for (int m = mbeg; m < mend; ++m) {
        if (m + 1 < mend) EW_LOADROW(m + 1, nxf, nxb, ny);
        const int r = (m < NPR) ? 0 : 1 + ((m - NPR) >> 11);
        if (r != rcur) { rcur = r;
#pragma unroll
            for (int j = 0; j < 4; ++j) { if (A.Y) gtv[j] = *(const f32x4*)(A.mod_y + (size_t)r * 6144 + A.gate_off + 4 * lane + 256 * j);
                if (A.H) { scv[j] = *(const f32x4*)(A.mod_h + (size_t)r * 6144 + A.sc_off + 4 * lane + 256 * j); shv[j] = *(const f32x4*)(A.mod_h + (size_t)r * 6144 + A.sh_off + 4 * lane + 256 * j); } } }
        f32x4 x[4];
        bf16_t* xb = (XIN == 1 || XOUT == 1) ? (bf16_t*)A.X + (size_t)m * 2048 + 1024 : nullptr;
        if (XIN == 1) {
#pragma unroll
            for (int j = 0; j < 4; ++j) x[j] = unpk4(__builtin_bit_cast(s16x4, cxb[j])); }
        else {
#pragma unroll
            for (int j = 0; j < 4; ++j) x[j] = cxf[j]; }
        if (A.Y) {
            f32x4 y[4]; float ss = 0.f;
#pragma unroll
            for (int j = 0; j < 4; ++j) { y[j] = unpk4(__builtin_bit_cast(s16x4, cy[j]));
                ss += (y[j][0] * y[j][0] + y[j][1] * y[j][1]) + (y[j][2] * y[j][2] + y[j][3] * y[j][3]); }
            const float rstd = rsqrtf(wave_sum(ss) * (1.f / DM) + EPSF);
#pragma unroll
            for (int j = 0; j < 4; ++j) x[j] = x[j] + gtv[j] * (y[j] * rstd * gyv[j]);
        }
        if (XOUT == 1) {
#pragma unroll
            for (int j = 0; j < 4; ++j) { u32x2 o; o.x = pk2(x[j][0], x[j][1]); o.y = pk2(x[j][2], x[j][3]); *(u32x2*)(xb + 4 * lane + 256 * j) = o; } }
        else if (XOUT == 2) {
#pragma unroll
            for (int j = 0; j < 4; ++j) *(f32x4*)(A.X + (size_t)m * DM + 4 * lane + 256 * j) = x[j]; }
        if (A.H) {
            float ss = 0.f;
#pragma unroll
            for (int j = 0; j < 4; ++j) ss += (x[j][0] * x[j][0] + x[j][1] * x[j][1]) + (x[j][2] * x[j][2] + x[j][3] * x[j][3]);
            const float rstd = rsqrtf(wave_sum(ss) * (1.f / DM) + EPSF);
#pragma unroll
            for (int j = 0; j < 4; ++j) { const f32x4 h = (x[j] * rstd * ghv[j]) * (scv[j] + 1.f) + shv[j]; u32x2 o; o.x = pk2(h[0], h[1]); o.y = pk2(h[2], h[3]);
                *(u32x2*)(A.H + (size_t)m * DM + 4 * lane + 256 * j) = o; }
        }
#pragma unroll
        for (int j = 0; j < 4; ++j) { cxf[j] = nxf[j]; cxb[j] = nxb[j]; cy[j] = ny[j]; }
    }
#undef EW_LOADROW
}
__device__ __forceinline__ void gate_phase(const bf16_t* of, int ldf, const bf16_t* ob, int ldb, const bf16_t* z, int ldz, const float* g, bf16_t* out, int gw, int ngw, int lane) {
    const int cg0 = (16 * lane) & 127; float gv[16];
#pragma unroll
    for (int e = 0; e < 16; ++e) gv[e] = g[cg0 + e];
    u32x4 ca[2], cb[2], cc[2], na[2], nb[2], nc[2];
#define GT_LOADROW(mm, av, bv, cv) do { const int m_ = (mm); _Pragma("unroll") for (int hh = 0; hh < 2; ++hh) { av[hh] = *(const u32x4*)(of + (size_t)m_ * ldf + 16 * lane + 8 * hh); \
        bv[hh] = *(const u32x4*)(ob + (size_t)m_ * ldb + 16 * lane + 8 * hh); cv[hh] = *(const u32x4*)(z + (size_t)m_ * ldz + 16 * lane + 8 * hh); } } while (0)
    if (gw < NT) GT_LOADROW(gw, ca, cb, cc);
    for (int m = gw; m < NT; m += ngw) {
        if (m + ngw < NT) GT_LOADROW(m + ngw, na, nb, nc);
        float s[16], zz[16];
#pragma unroll
        for (int hh = 0; hh < 2; ++hh) {
            const u32x4 a = ca[hh], b = cb[hh], c = cc[hh];
#pragma unroll
            for (int e = 0; e < 4; ++e) { s[8 * hh + 2 * e] = bf2f(a[e] & 0xffffu) + bf2f(b[e] & 0xffffu); s[8 * hh + 2 * e + 1] = bf2f(a[e] >> 16) + bf2f(b[e] >> 16);
                zz[8 * hh + 2 * e] = bf2f(c[e] & 0xffffu); zz[8 * hh + 2 * e + 1] = bf2f(c[e] >> 16); }
        }
        float ss = 0.f;
#pragma unroll
        for (int e = 0; e < 16; ++e) ss += s[e] * s[e];
        ss += __int_as_float(__builtin_amdgcn_update_dpp(0, __float_as_int(ss), 0xB1, 0xf, 0xf, false));
        ss += __int_as_float(__builtin_amdgcn_update_dpp(0, __float_as_int(ss), 0x4E, 0xf, 0xf, false));
        ss += __int_as_float(__builtin_amdgcn_update_dpp(0, __float_as_int(ss), 0x141, 0xf, 0xf, false));
        const float rstd = rsqrtf(ss * (1.f / 128.f) + EPSF);
        u32x4 o[2];
#pragma unroll
        for (int hh = 0; hh < 2; ++hh)
#pragma unroll
            for (int e = 0; e < 4; ++e) { const int i0 = 8 * hh + 2 * e; const float v0 = s[i0] * rstd * gv[i0] * zz[i0], v1 = s[i0 + 1] * rstd * gv[i0 + 1] * zz[i0 + 1]; o[hh][e] = pk2(v0, v1); }
        *(u32x4*)(out + (size_t)m * DM + 16 * lane) = o[0]; *(u32x4*)(out + (size_t)m * DM + 16 * lane + 8) = o[1];
#pragma unroll
        for (int hh = 0; hh < 2; ++hh) { ca[hh] = na[hh]; cb[hh] = nb[hh]; cc[hh] = nc[hh]; }
    }
#undef GT_LOADROW
}

__device__ __forceinline__ int scan_item_of(int rnd, int bid, int G) {
    if (G == 256) { if (rnd == 0) return bid; if (rnd == 1 && bid >= 128) return bid + 128; return -1; }
    const int it = bid + rnd * G; return it < 384 ? it : -1;
}

constexpr int G_QS = 0, G_KS = 17408, G_KBG = 34816, G_KTL = 53248, G_VB = 71680, G_NW = 90112, G_QK = 107520, G_CW = 116736, G_LB = 124416, G_LD = 133632, G_TB = 137984, G_OS = G_LB, G_GW = 141824, G_BW = 143872, G_EW = 145920;
__device__ __forceinline__ void conv_unit(LAS unsigned char* lds, CPP P, int unit, bool load_cw) {
    int tid_ = threadIdx.x; asm volatile("" : "+v"(tid_)); const int tid = tid_;
    const int b = unit >> 8, rowg = (unit >> 3) & 31, h = unit & 7;
    bf16_t* proj = (bf16_t*)(P->ws + WS_BIG);
    LAS float* CW = (LAS float*)(lds + G_CW);
    if (load_cw) { for (int i = tid; i < 3 * 5 * 128; i += NTHREADS) { const int sec = i / 640, tap = (i / 128) % 5, cc = i & 127; CW[i] = P->in[10][tap * 3072 + sec * 1024 + h * 128 + cc]; } }
    const int c8 = tid & 15, r = tid >> 4, tlo = 2 * r;
    bf16_t* pbase = proj + (size_t)(NPR + b * TS + rowg * 64 + tlo) * LD0 + h * 128 + c8 * 8;
    u32x4 rq[6], rk[6], rv[6];
#pragma unroll
    for (int i = 0; i < 6; ++i) { const int tt = tlo - 2 + i; const bool ok = (tt >= 0 && tt < 64); const bf16_t* pr = pbase + (ptrdiff_t)(ok ? (i - 2) : 0) * LD0;
        const u32x4 a = *(const u32x4*)(pr), bb = *(const u32x4*)(pr + 1024), c = *(const u32x4*)(pr + 2048); const u32x4 z = (u32x4){0u, 0u, 0u, 0u}; rq[i] = ok ? a : z; rk[i] = ok ? bb : z; rv[i] = ok ? c : z; }
    __syncthreads();
#define CU_CONV(sec, rw, al, ah) do { f32x2 al2[4], ah2[4]; _Pragma("unroll") for (int e = 0; e < 4; ++e) { al2[e] = (f32x2){0.f, 0.f}; ah2[e] = (f32x2){0.f, 0.f}; } \
        _Pragma("unroll") for (int i = 0; i < 6; ++i) { f32x2 x2[4]; \
            _Pragma("unroll") for (int e = 0; e < 4; ++e) { x2[e][0] = __uint_as_float(rw[i][e] << 16); x2[e][1] = __uint_as_float(rw[i][e] & 0xffff0000u); } \
            if (i < 5) { const LAS float* cw = CW + ((sec) * 5 + i) * 128 + c8 * 8; const f32x4 w0 = *(const LAS f32x4*)cw, w1 = *(const LAS f32x4*)(cw + 4); \
                al2[0] += x2[0] * (f32x2){w0[0], w0[1]}; al2[1] += x2[1] * (f32x2){w0[2], w0[3]}; al2[2] += x2[2] * (f32x2){w1[0], w1[1]}; al2[3] += x2[3] * (f32x2){w1[2], w1[3]}; } \
            if (i > 0) { const LAS float* cw = CW + ((sec) * 5 + i - 1) * 128 + c8 * 8; const f32x4 w0 = *(const LAS f32x4*)cw, w1 = *(const LAS f32x4*)(cw + 4); \
                ah2[0] += x2[0] * (f32x2){w0[0], w0[1]}; ah2[1] += x2[1] * (f32x2){w0[2], w0[3]}; ah2[2] += x2[2] * (f32x2){w1[0], w1[1]}; ah2[3] += x2[3] * (f32x2){w1[2], w1[3]}; } } \
        _Pragma("unroll") for (int e = 0; e < 4; ++e) { al[2 * e] = silu_f(al2[e][0]); al[2 * e + 1] = silu_f(al2[e][1]); ah[2 * e] = silu_f(ah2[e][0]); ah[2 * e + 1] = silu_f(ah2[e][1]); } } while (0)
#define CU_STORE(sec, al, ah, rl, rh) do { u32x4 lo4, hi4; _Pragma("unroll") for (int e = 0; e < 4; ++e) { lo4[e] = pk2(al[2 * e] * (rl), al[2 * e + 1] * (rl)); hi4[e] = pk2(ah[2 * e] * (rh), ah[2 * e + 1] * (rh)); } \
        *(u32x4*)(pbase + (sec) * 1024) = lo4; *(u32x4*)(pbase + LD0 + (sec) * 1024) = hi4; } while (0)
    float al[8], ah[8];
#pragma unroll
    for (int sec = 0; sec < 3; ++sec) {
        if (sec == 0) CU_CONV(0, rq, al, ah); else if (sec == 1) CU_CONV(1, rk, al, ah); else CU_CONV(2, rv, al, ah);
        float rl = 1.f, rh = 1.f;
        if (sec < 2) { float sl = 0.f, sh = 0.f;
#pragma unroll
            for (int e = 0; e < 8; ++e) { sl += al[e] * al[e]; sh += ah[e] * ah[e]; }
#pragma unroll
            for (int o = 1; o < 16; o <<= 1) { sl += __shfl_xor(sl, o); sh += __shfl_xor(sh, o); }
            const float scl = (sec == 0) ? 0.08838834764831845f : 1.f; rl = rsqrtf(sl + EPSF) * scl; rh = rsqrtf(sh + EPSF) * scl; }
        CU_STORE(sec, al, ah, rl, rh);
    }
#undef CU_CONV
#undef CU_STORE
    __syncthreads();
}

__device__ __forceinline__ void gdn_item(LAS unsigned char* lds, CPP P, int item) {
    int tid_ = threadIdx.x; asm volatile("" : "+v"(tid_)); const int tid0 = tid_, lane0 = tid0 & 63, wid = __builtin_amdgcn_readfirstlane(tid0 >> 6), fr0 = lane0 & 15, fq0 = lane0 >> 4;
    const bool samp = item < 128; const int p = samp ? item : item - 128;
    const int b = p >> 4, h = (p >> 1) & 7, d = p & 1;
    const int T = samp ? TS : TP, m0 = samp ? NPR + b * TS : b * TP, NC = T / 64;
    const bf16_t* proj = (const bf16_t*)(P->ws + WS_BIG);
    bf16_t* od = (bf16_t*)(P->ws + (d ? WS_210 : WS_170));
    LAS bf16_t* QS = (LAS bf16_t*)(lds + G_QS); LAS bf16_t* KS = (LAS bf16_t*)(lds + G_KS); LAS bf16_t* KBG = (LAS bf16_t*)(lds + G_KBG); LAS bf16_t* KTL = (LAS bf16_t*)(lds + G_KTL);
    LAS bf16_t* VB = (LAS bf16_t*)(lds + G_VB); LAS bf16_t* NW = (LAS bf16_t*)(lds + G_NW); LAS bf16_t* QK = (LAS bf16_t*)(lds + G_QK); LAS bf16_t* LB = (LAS bf16_t*)(lds + G_LB);
    LAS float* LD = (LAS float*)(lds + G_LD); LAS bf16_t* TB = (LAS bf16_t*)(lds + G_TB); LAS float* CW = (LAS float*)(lds + G_CW); LAS bf16_t* OS = (LAS bf16_t*)(lds + G_OS);
    for (int i = tid0; i < 3 * 5 * 128; i += NTHREADS) { const int sec = i / 640, tap = (i / 128) % 5, cc = i & 127; CW[i] = P->in[10][tap * 3072 + sec * 1024 + h * 128 + cc]; }
    const float A_neg = -__expf(P->in[11][d * 8 + h]), dtb = P->in[12][d * 8 + h];
    f32x4 S[8];
    if (samp) { const float* s0 = P->in[2] + ((size_t)(b * 2 + d) * 8 + h) * 16384;
#pragma unroll
        for (int kb = 0; kb < 8; ++kb)
#pragma unroll
            for (int j = 0; j < 4; ++j) S[kb][j] = s0[(16 * kb + 4 * fq0 + j) * 128 + 16 * wid + fr0]; }
    else {
#pragma unroll
        for (int kb = 0; kb < 8; ++kb) S[kb] = (f32x4){0.f, 0.f, 0.f, 0.f}; }
    LAS float* GW = (LAS float*)(lds + G_GW) + wid * 64; LAS float* BW = (LAS float*)(lds + G_BW) + wid * 64; LAS float* EW = (LAS float*)(lds + G_EW) + wid * 64;
    u32x4 rq[6], rk[6], rv[6]; unsigned gbr, gar;
#define TOKN(nn, i) (d ? (T - 1 - (64 * (nn) + (i))) : (64 * (nn) + (i)))
#define GDN_ISSUE(nn, tidx) do { const int c8_ = (tidx) & 15, r_ = (tidx) >> 4; const int tA_ = TOKN(nn, 2 * r_), tB_ = TOKN(nn, 2 * r_ + 1); const int tlo_ = tA_ < tB_ ? tA_ : tB_; \
        const bf16_t* pb_ = proj + (size_t)(m0 + tlo_) * LD0 + h * 128 + c8_ * 8; \
        if (samp) { rq[2] = *(const u32x4*)(pb_); rk[2] = *(const u32x4*)(pb_ + 1024); rv[2] = *(const u32x4*)(pb_ + 2048); rq[3] = *(const u32x4*)(pb_ + LD0); rk[3] = *(const u32x4*)(pb_ + LD0 + 1024); rv[3] = *(const u32x4*)(pb_ + LD0 + 2048); } \
        else { _Pragma("unroll") for (int i = 0; i < 6; ++i) { const int tt = tlo_ - 2 + i; const bool ok = (tt >= 0 && tt < T); const bf16_t* pr_ = pb_ + (ptrdiff_t)(ok ? (i - 2) : 0) * LD0; \
            const u32x4 a_ = *(const u32x4*)(pr_), b_ = *(const u32x4*)(pr_ + 1024), c_ = *(const u32x4*)(pr_ + 2048); const u32x4 z_ = (u32x4){0u, 0u, 0u, 0u}; rq[i] = ok ? a_ : z_; rk[i] = ok ? b_ : z_; rv[i] = ok ? c_ : z_; } } \
        const bf16_t* pg_ = proj + (size_t)(m0 + TOKN(nn, (tidx) & 63)) * LD0 + 4096 + d * 8 + h; gbr = pg_[0]; gar = pg_[16]; } while (0)
    GDN_ISSUE(0, tid0);
    LDS_SYNC();
    for (int n = 0; n < NC; ++n) {
        int tid = tid0; asm volatile("" : "+v"(tid));
        const int lane = tid & 63, fr = lane & 15, fq = lane >> 4;
        float Glast;
        { const float braw = bf2f(gbr), araw = bf2f(gar);
          const float beta_l = sigmoid_f(braw); const float xx = araw + dtb; const float sp = (xx > 20.f) ? xx : __logf(1.f + __expf(xx)); float g = A_neg * sp;
          { int x_;
#define DPPADD(ctrl, rmask) do { x_ = __builtin_amdgcn_update_dpp(0, __float_as_int(g), (ctrl), (rmask), 0xf, false); g += __int_as_float(x_); } while (0)
            DPPADD(0x111, 0xf); DPPADD(0x112, 0xf); DPPADD(0x114, 0xf); DPPADD(0x118, 0xf); DPPADD(0x142, 0xa); DPPADD(0x143, 0xc);
#undef DPPADD
          }
          GW[lane] = g; BW[lane] = beta_l; EW[lane] = __expf(g); Glast = __int_as_float(__builtin_amdgcn_readlane(__float_as_int(g), 63)); }
_Pragma("unroll")
        for (int rep_ = 0; rep_ < (PROBE_GCONV2 ? 2 : 1); ++rep_)
        { const int c8 = tid & 15, r = tid >> 4;
          const int rlo = d ? 2 * r + 1 : 2 * r, rhi = d ? 2 * r : 2 * r + 1;
          const float be_lo = BW[rlo], be_hi = BW[rhi], G_lo = GW[rlo], G_hi = GW[rhi];
          const int tlo_off = 4 * ((rlo >> 2) ^ c8) + (rlo & 3), thi_off = 4 * ((rhi >> 2) ^ c8) + (rhi & 3);
#define GDN_CONV(sec, rw, al, ah) do { f32x2 al2[4], ah2[4]; _Pragma("unroll") for (int e = 0; e < 4; ++e) { al2[e] = (f32x2){0.f, 0.f}; ah2[e] = (f32x2){0.f, 0.f}; } \
              _Pragma("unroll") for (int i = 0; i < 6; ++i) { f32x2 x2[4]; \
                  _Pragma("unroll") for (int e = 0; e < 4; ++e) { x2[e][0] = __uint_as_float(rw[i][e] << 16); x2[e][1] = __uint_as_float(rw[i][e] & 0xffff0000u); } \
                  if (i < 5) { const LAS float* cw = CW + ((sec) * 5 + i) * 128 + c8 * 8; const f32x4 w0 = *(const LAS f32x4*)cw, w1 = *(const LAS f32x4*)(cw + 4); \
                      al2[0] += x2[0] * (f32x2){w0[0], w0[1]}; al2[1] += x2[1] * (f32x2){w0[2], w0[3]}; al2[2] += x2[2] * (f32x2){w1[0], w1[1]}; al2[3] += x2[3] * (f32x2){w1[2], w1[3]}; } \
                  if (i > 0) { const LAS float* cw = CW + ((sec) * 5 + i - 1) * 128 + c8 * 8; const f32x4 w0 = *(const LAS f32x4*)cw, w1 = *(const LAS f32x4*)(cw + 4); \
                      ah2[0] += x2[0] * (f32x2){w0[0], w0[1]}; ah2[1] += x2[1] * (f32x2){w0[2], w0[3]}; ah2[2] += x2[2] * (f32x2){w1[0], w1[1]}; ah2[3] += x2[3] * (f32x2){w1[2], w1[3]}; } } \
              _Pragma("unroll") for (int e = 0; e < 4; ++e) { al[2 * e] = silu_f(al2[e][0]); al[2 * e + 1] = silu_f(al2[e][1]); ah[2 * e] = silu_f(ah2[e][0]); ah[2 * e + 1] = silu_f(ah2[e][1]); } } while (0)
#define GDN_NORM(al, ah, scl, rl, rh) do { float sl = 0.f, sh = 0.f; \
              _Pragma("unroll") for (int e = 0; e < 8; ++e) { sl += al[e] * al[e]; sh += ah[e] * ah[e]; } \
              _Pragma("unroll") for (int o = 1; o < 16; o <<= 1) { sl += __shfl_xor(sl, o); sh += __shfl_xor(sh, o); } \
              rl = rsqrtf(sl + EPSF) * (scl); rh = rsqrtf(sh + EPSF) * (scl); } while (0)
          float al[8], ah[8]; float rl, rh;
          if (samp) {
              *(LAS u32x4*)(QS + rlo * 136 + c8 * 8) = rq[2]; *(LAS u32x4*)(QS + rhi * 136 + c8 * 8) = rq[3];
              *(LAS u32x4*)(KS + rlo * 136 + c8 * 8) = rk[2]; *(LAS u32x4*)(KS + rhi * 136 + c8 * 8) = rk[3];
#pragma unroll
              for (int e = 0; e < 4; ++e) { al[2 * e] = __uint_as_float(rk[2][e] << 16); al[2 * e + 1] = __uint_as_float(rk[2][e] & 0xffff0000u); ah[2 * e] = __uint_as_float(rk[3][e] << 16); ah[2 * e + 1] = __uint_as_float(rk[3][e] & 0xffff0000u); }
              { const float bgl = be_lo * __expf(G_lo), bgh = be_hi * __expf(G_hi), tll = __expf(Glast - G_lo), tlh = __expf(Glast - G_hi);
#pragma unroll
                for (int e = 0; e < 8; ++e) { const int cb = (c8 * 8 + e) * 72;
                    KBG[cb + tlo_off] = (bf16_t)(pk2(al[e] * bgl, 0.f) & 0xffffu); KBG[cb + thi_off] = (bf16_t)(pk2(ah[e] * bgh, 0.f) & 0xffffu);
                    KTL[cb + tlo_off] = (bf16_t)(pk2(al[e] * tll, 0.f) & 0xffffu); KTL[cb + thi_off] = (bf16_t)(pk2(ah[e] * tlh, 0.f) & 0xffffu); } }
#pragma unroll
              for (int e = 0; e < 4; ++e) { al[2 * e] = __uint_as_float(rv[2][e] << 16); al[2 * e + 1] = __uint_as_float(rv[2][e] & 0xffff0000u); ah[2 * e] = __uint_as_float(rv[3][e] << 16); ah[2 * e + 1] = __uint_as_float(rv[3][e] & 0xffff0000u); }
#pragma unroll
              for (int e = 0; e < 8; ++e) { const int cb = (c8 * 8 + e) * 72; VB[cb + tlo_off] = (bf16_t)(pk2(al[e] * be_lo, 0.f) & 0xffffu); VB[cb + thi_off] = (bf16_t)(pk2(ah[e] * be_hi, 0.f) & 0xffffu); }
          } else {
          GDN_CONV(0, rq, al, ah);
          GDN_NORM(al, ah, 0.08838834764831845f, rl, rh);
          { u32x4 lo4, hi4;
#pragma unroll
            for (int e = 0; e < 4; ++e) { lo4[e] = pk2(al[2 * e] * rl, al[2 * e + 1] * rl); hi4[e] = pk2(ah[2 * e] * rh, ah[2 * e + 1] * rh); }
            *(LAS u32x4*)(QS + rlo * 136 + c8 * 8) = lo4; *(LAS u32x4*)(QS + rhi * 136 + c8 * 8) = hi4; }
          GDN_CONV(1, rk, al, ah);
          GDN_NORM(al, ah, 1.f, rl, rh);
          { u32x4 lo4, hi4;
#pragma unroll
            for (int e = 0; e < 4; ++e) { lo4[e] = pk2(al[2 * e] * rl, al[2 * e + 1] * rl); hi4[e] = pk2(ah[2 * e] * rh, ah[2 * e + 1] * rh); }
            *(LAS u32x4*)(KS + rlo * 136 + c8 * 8) = lo4; *(LAS u32x4*)(KS + rhi * 136 + c8 * 8) = hi4;
            const float bgl = rl * be_lo * __expf(G_lo), bgh = rh * be_hi * __expf(G_hi), tll = rl * __expf(Glast - G_lo), tlh = rh * __expf(Glast - G_hi);
#pragma unroll
            for (int e = 0; e < 8; ++e) { const int cb = (c8 * 8 + e) * 72;
                KBG[cb + tlo_off] = (bf16_t)(pk2(al[e] * bgl, 0.f) & 0xffffu); KBG[cb + thi_off] = (bf16_t)(pk2(ah[e] * bgh, 0.f) & 0xffffu);
                KTL[cb + tlo_off] = (bf16_t)(pk2(al[e] * tll, 0.f) & 0xffffu); KTL[cb + thi_off] = (bf16_t)(pk2(ah[e] * tlh, 0.f) & 0xffffu); } }
          GDN_CONV(2, rv, al, ah);
#pragma unroll
          for (int e = 0; e < 8; ++e) { const int cb = (c8 * 8 + e) * 72; VB[cb + tlo_off] = (bf16_t)(pk2(al[e] * be_lo, 0.f) & 0xffffu); VB[cb + thi_off] = (bf16_t)(pk2(ah[e] * be_hi, 0.f) & 0xffffu); }
          }
#undef GDN_CONV
#undef GDN_NORM
        }
        LDS_SYNC();
        f32x4 U[4];
        for (int rep2_ = 0; rep2_ < (PROBE_GSOLVE2 ? 2 : 1); ++rep2_) {
        { const int ntile = (wid < 4) ? 2 : 3;
          for (int tq = 0; tq < ntile; ++tq) {
            int ty, ci, si;
            if (wid < 4 && tq == 0) { ty = 0; ci = wid; si = wid; }
            else { const int k = (wid < 4) ? wid : 4 + 3 * (wid - 4) + tq;
                   if (k < 6) { ty = 0; ci = (k < 1) ? 1 : (k < 3) ? 2 : 3; si = k - (ci * (ci - 1)) / 2; }
                   else { ty = 1; const int idx = k - 6; ci = (idx >= 6) ? 3 : (idx >= 3) ? 2 : (idx >= 1) ? 1 : 0; si = idx - (ci * (ci + 1)) / 2; } }
            const LAS bf16_t* Bsrc = ty ? QS : KS; f32x4 acc = (f32x4){0.f, 0.f, 0.f, 0.f};
#pragma unroll
            for (int ks = 0; ks < 4; ++ks) { const bf16x8 a = *(const LAS bf16x8*)(KS + (16 * si + fr) * 136 + 32 * ks + 8 * fq); const bf16x8 bb = *(const LAS bf16x8*)(Bsrc + (16 * ci + fr) * 136 + 32 * ks + 8 * fq); acc = mfma32(a, bb, acc); }
            const int c = 16 * ci + fr; const float Gc = GW[c], bc = BW[c]; const f32x4 Gs4 = *(const LAS f32x4*)(GW + 16 * si + 4 * fq);
            float val[4];
#pragma unroll
            for (int j = 0; j < 4; ++j) { const int s = 16 * si + 4 * fq + j; const float Gs = Gs4[j];
                if (ty == 0) val[j] = (s < c) ? bc * acc[j] * __expf(Gc - Gs) : 0.f; else val[j] = (s <= c) ? acc[j] * __expf(Gc - Gs) : 0.f; }
            if (ty == 0) { u32x2 o; o.x = pk2(-val[0], -val[1]); o.y = pk2(-val[2], -val[3]); *(LAS u32x2*)(LB + c * 72 + 16 * si + 4 * fq) = o; }
            else { u32x2 o; o.x = pk2(val[0], val[1]); o.y = pk2(val[2], val[3]); *(LAS u32x2*)(QK + c * 72 + 16 * si + 4 * fq) = o; }
            if (wid < 4 && tq == 0) {
#pragma unroll
                for (int j = 0; j < 4; ++j) LD[(wid * 16 + fr) * 17 + 4 * fq + j] = val[j];
                if (lane < 16) { const LAS float* Lp = LD + wid * 16 * 17; float Tc[16];
#pragma unroll
                    for (int r = 0; r < 16; ++r) { float a = (r == lane) ? 1.f : 0.f;
#pragma unroll
                        for (int s = 0; s < r; ++s) a -= Lp[r * 17 + s] * Tc[s];
                        Tc[r] = a; }
#pragma unroll
                    for (int r = 0; r < 16; ++r) TB[(wid * 16 + r) * 20 + lane] = (bf16_t)(pk2(Tc[r], 0.f) & 0xffffu); }
            }
          } }
        LDS_SYNC();
        { s16x4 Td[4];
#pragma unroll
          for (int i = 0; i < 4; ++i) Td[i] = *(const LAS s16x4*)(TB + (i * 16 + fr) * 20 + 4 * fq);
          s16x4 Ln[6];
          Ln[0] = *(const LAS s16x4*)(LB + (16 + fr) * 72 + 4 * fq); Ln[1] = *(const LAS s16x4*)(LB + (32 + fr) * 72 + 4 * fq); Ln[2] = *(const LAS s16x4*)(LB + (32 + fr) * 72 + 16 + 4 * fq);
          Ln[3] = *(const LAS s16x4*)(LB + (48 + fr) * 72 + 4 * fq); Ln[4] = *(const LAS s16x4*)(LB + (48 + fr) * 72 + 16 + 4 * fq); Ln[5] = *(const LAS s16x4*)(LB + (48 + fr) * 72 + 32 + 4 * fq);
          const f32x4 zero = (f32x4){0.f, 0.f, 0.f, 0.f};
          const int swz = 2 * wid + (fr >> 3);
#pragma unroll
          for (int part = 0; part < 2; ++part) { const LAS bf16_t* RB = (part ? KBG : VB) + (16 * wid + fr) * 72;
              const s16x4 B0 = *(const LAS s16x4*)(RB + 4 * ((0 + fq) ^ swz)), B1 = *(const LAS s16x4*)(RB + 4 * ((4 + fq) ^ swz)), B2 = *(const LAS s16x4*)(RB + 4 * ((8 + fq) ^ swz)), B3 = *(const LAS s16x4*)(RB + 4 * ((12 + fq) ^ swz));
              f32x4 X0 = mfma16(Td[0], B0, zero); const s16x4 x0 = pk4(X0);
              f32x4 Y = mfma16(Ln[0], x0, unpk4(B1)); f32x4 X1 = mfma16(Td[1], pk4(Y), zero); const s16x4 x1 = pk4(X1);
              Y = mfma16(Ln[1], x0, unpk4(B2)); Y = mfma16(Ln[2], x1, Y); f32x4 X2 = mfma16(Td[2], pk4(Y), zero); const s16x4 x2 = pk4(X2);
              Y = mfma16(Ln[3], x0, unpk4(B3)); Y = mfma16(Ln[4], x1, Y); Y = mfma16(Ln[5], x2, Y); f32x4 X3 = mfma16(Td[3], pk4(Y), zero);
              if (part == 0) { U[0] = X0; U[1] = X1; U[2] = X2; U[3] = X3; }
              else {
#pragma unroll
                  for (int j = 0; j < 4; ++j) { NW[(4 * fq + j) * 136 + 16 * wid + fr] = (bf16_t)(pk2(-X0[j], 0.f) & 0xffffu); NW[(16 + 4 * fq + j) * 136 + 16 * wid + fr] = (bf16_t)(pk2(-X1[j], 0.f) & 0xffffu);
                      NW[(32 + 4 * fq + j) * 136 + 16 * wid + fr] = (bf16_t)(pk2(-X2[j], 0.f) & 0xffffu); NW[(48 + 4 * fq + j) * 136 + 16 * wid + fr] = (bf16_t)(pk2(-X3[j], 0.f) & 0xffffu); } }
          } }
        LDS_SYNC();
        }
        if (n + 1 < NC) GDN_ISSUE(n + 1, tid);
        { s16x4 Sb[8];
#pragma unroll
          for (int kb = 0; kb < 8; ++kb) Sb[kb] = pk4(S[kb]);
          f32x4 oa[4];
#pragma unroll
          for (int i = 0; i < 4; ++i) { oa[i] = (f32x4){0.f, 0.f, 0.f, 0.f};
#pragma unroll
              for (int kb = 0; kb < 8; ++kb) { const s16x4 a = *(const LAS s16x4*)(NW + (16 * i + fr) * 136 + 16 * kb + 4 * fq); U[i] = mfma16(a, Sb[kb], U[i]);
                  const s16x4 a2 = *(const LAS s16x4*)(QS + (16 * i + fr) * 136 + 16 * kb + 4 * fq); oa[i] = mfma16(a2, Sb[kb], oa[i]); } }
#pragma unroll
          for (int i = 0; i < 4; ++i) oa[i] = oa[i] * *(const LAS f32x4*)(EW + 16 * i + 4 * fq);
          s16x4 vb[4];
#pragma unroll
          for (int i = 0; i < 4; ++i) vb[i] = pk4(U[i]);
#pragma unroll
          for (int i = 0; i < 4; ++i)
#pragma unroll
              for (int si = 0; si <= i; ++si) { const s16x4 a = *(const LAS s16x4*)(QK + (16 * i + fr) * 72 + 16 * si + 4 * fq); oa[i] = mfma16(a, vb[si], oa[i]); }
          const float gl = __expf(Glast);
#pragma unroll
          for (int kb = 0; kb < 8; ++kb) { S[kb] = S[kb] * gl; const int swk = 2 * kb + (fr >> 3);
#pragma unroll
              for (int i = 0; i < 4; ++i) { const s16x4 a = *(const LAS s16x4*)(KTL + (16 * kb + fr) * 72 + 4 * ((4 * i + fq) ^ swk)); S[kb] = mfma16(a, vb[i], S[kb]); } }
#pragma unroll
          for (int i = 0; i < 4; ++i)
#pragma unroll
              for (int j = 0; j < 4; ++j) OS[(16 * i + 4 * fq + j) * 136 + 16 * wid + fr] = (bf16_t)(pk2(oa[i][j], 0.f) & 0xffffu);
        }
        LDS_SYNC();
        { const int row = tid >> 3, seg = tid & 7; const int t = TOKN(n, row);
          const u32x4 v0 = *(const LAS u32x4*)(OS + row * 136 + seg * 16), v1 = *(const LAS u32x4*)(OS + row * 136 + seg * 16 + 8);
          bf16_t* dst = od + (size_t)(m0 + t) * DM + h * 128 + seg * 16; *(u32x4*)dst = v0; *(u32x4*)(dst + 8) = v1; }
    }
#undef GDN_ISSUE
#undef TOKN
    LDS_SYNC();
    if (!samp) { float* so = P->out + OUT_SG + ((size_t)(b * 2 + d) * 8 + h) * 16384;
#pragma unroll
        for (int kb = 0; kb < 8; ++kb)
#pragma unroll
            for (int j = 0; j < 4; ++j) so[(16 * kb + 4 * fq0 + j) * 128 + 16 * wid + fr0] = S[kb][j]; }
}

constexpr int H_QI = 0, H_KO = 17408, H_KT = 34816, H_VT = 53248, H_FL = 71680;
template <bool DUMMY>
__device__ __forceinline__ void hgrn_item(LAS unsigned char* lds, CPP P, int item) {
    int tid_ = threadIdx.x; asm volatile("" : "+v"(tid_)); const int tid = tid_, lane = tid & 63, wid = __builtin_amdgcn_readfirstlane(tid >> 6), fr = lane & 15, fq = lane >> 4;
    const bool samp = item < 128; const int p = samp ? item : item - 128;
    const int b = p >> 4, h = (p >> 1) & 7, d = p & 1;
    const int T = samp ? TS : TP, m0 = samp ? NPR + b * TS : b * TP, NC = T / 64;
    bf16_t* proj = (bf16_t*)(P->ws + WS_BIG);
    LAS bf16_t* QI = (LAS bf16_t*)(lds + H_QI); LAS bf16_t* KO = (LAS bf16_t*)(lds + H_KO); LAS bf16_t* KT = (LAS bf16_t*)(lds + H_KT); LAS bf16_t* VT = (LAS bf16_t*)(lds + H_VT); LAS float* FL = (LAS float*)(lds + H_FL);
    const int c = tid & 127, cc = tid >> 7;
    f32x4 S[8];
    if (samp) { const float* s0 = P->in[3] + ((size_t)(b * 2 + d) * 8 + h) * 16384;
#pragma unroll
        for (int kb = 0; kb < 8; ++kb)
#pragma unroll
            for (int j = 0; j < 4; ++j) S[kb][j] = s0[(16 * kb + 4 * fq + j) * 128 + 16 * wid + fr]; }
    else {
#pragma unroll
        for (int kb = 0; kb < 8; ++kb) S[kb] = (f32x4){0.f, 0.f, 0.f, 0.f}; }
    const size_t colq = (size_t)h * 128, colf = (size_t)1024 + d * 1024 + h * 128, colv = (size_t)3072 + h * 128;
    unsigned pq[16], pf[16], pv[16];
    const int tsgn = d ? -1 : 1;
#define H_T0(nn) (d ? (T - 1 - 64 * (nn)) : 64 * (nn))
#define H_ISSUE(nn) do { const bf16_t* pr0_ = proj + (size_t)(m0 + H_T0(nn)) * LD1 + (ptrdiff_t)(tsgn * 16 * cc) * LD1 + c; const ptrdiff_t st_ = (ptrdiff_t)tsgn * LD1; \
        _Pragma("unroll") for (int ta = 0; ta < 16; ++ta) { const bf16_t* pr_ = pr0_ + ta * st_; pq[ta] = pr_[colq]; pf[ta] = pr_[colf]; pv[ta] = pr_[colv]; } } while (0)
    H_ISSUE(0);
    for (int n = 0; n < NC; ++n) {
        auto tok = [&](int i) -> int { return d ? (T - 1 - (64 * n + i)) : (64 * n + i); };
        { float ko[16]; float ebc = 1.f;
#pragma unroll
          for (int ta = 0; ta < 16; ++ta) { const int i = 16 * cc + ta;
              const float qs = bf2f(pq[ta]), f = bf2f(pf[ta]);
              ebc *= f; ko[ta] = (1.f - f) * __builtin_amdgcn_rcpf(ebc);
              QI[i * 136 + c] = (bf16_t)(pk2(qs * ebc, 0.f) & 0xffffu); KO[i * 136 + c] = (bf16_t)(pk2(ko[ta], 0.f) & 0xffffu); }
          u32x4 k0, k1, v0, v1;
#pragma unroll
          for (int e = 0; e < 4; ++e) { k0[e] = pk2(ko[2 * e] * ebc, ko[2 * e + 1] * ebc); k1[e] = pk2(ko[8 + 2 * e] * ebc, ko[9 + 2 * e] * ebc);
              v0[e] = pv[2 * e] | (pv[2 * e + 1] << 16); v1[e] = pv[8 + 2 * e] | (pv[9 + 2 * e] << 16); }
          *(LAS u32x4*)(KT + c * 72 + 16 * cc) = k0; *(LAS u32x4*)(KT + c * 72 + 16 * cc + 8) = k1; *(LAS u32x4*)(VT + c * 72 + 16 * cc) = v0; *(LAS u32x4*)(VT + c * 72 + 16 * cc + 8) = v1;
          FL[cc * 128 + c] = ebc; }
        LDS_SYNC();
        if (n + 1 < NC) H_ISSUE(n + 1);
#pragma unroll 1
        for (int q4 = 0; q4 < 4; ++q4) {
            f32x4 at = (f32x4){0.f, 0.f, 0.f, 0.f};
#pragma unroll
            for (int ks = 0; ks < 4; ++ks) { const bf16x8 a = *(const LAS bf16x8*)(KO + (16 * q4 + fr) * 136 + 32 * ks + 8 * fq); const bf16x8 bb = *(const LAS bf16x8*)(QI + (16 * q4 + fr) * 136 + 32 * ks + 8 * fq); at = mfma32(a, bb, at); }
#pragma unroll
            for (int j = 0; j < 4; ++j) at[j] = (4 * fq + j <= fr) ? at[j] : 0.f;
            const s16x4 atb = pk4(at);
            f32x4 oa = (f32x4){0.f, 0.f, 0.f, 0.f};
#pragma unroll
            for (int kp = 0; kp < 4; ++kp) { const LAS bf16_t* pa = QI + (16 * q4 + fr) * 136 + 32 * kp + 4 * fq;
                oa = mfma32(__builtin_shufflevector(*(const LAS s16x4*)pa, *(const LAS s16x4*)(pa + 16), 0, 1, 2, 3, 4, 5, 6, 7), __builtin_shufflevector(pk4(S[2 * kp]), pk4(S[2 * kp + 1]), 0, 1, 2, 3, 4, 5, 6, 7), oa); }
            const s16x4 bv = *(const LAS s16x4*)(VT + (16 * wid + fr) * 72 + 16 * q4 + 4 * fq);
            oa = mfma16(atb, bv, oa);
#pragma unroll
            for (int kb = 0; kb < 8; ++kb) { const f32x4 fl = *(const LAS f32x4*)(FL + q4 * 128 + 16 * kb + 4 * fq); S[kb] = S[kb] * fl;
                const s16x4 a = *(const LAS s16x4*)(KT + (16 * kb + fr) * 72 + 16 * q4 + 4 * fq); S[kb] = mfma16(a, bv, S[kb]); }
            { bf16_t* op0 = DUMMY ? (bf16_t*)(P->ws + WS_200) + (size_t)(m0 + H_T0(n) + tsgn * (16 * q4 + 4 * fq)) * DM + h * 128 + 16 * wid + fr : proj + (size_t)(m0 + H_T0(n) + tsgn * (16 * q4 + 4 * fq)) * LD1 + colf + 16 * wid + fr; const ptrdiff_t ost = (ptrdiff_t)tsgn * (DUMMY ? DM : LD1);
#pragma unroll
            for (int j = 0; j < 4; ++j) op0[j * ost] = (bf16_t)(pk2(oa[j], 0.f) & 0xffffu); }
        }
        LDS_SYNC();
    }
    if (!samp) { float* so = P->out + OUT_SH + ((size_t)(b * 2 + d) * 8 + h) * 16384;
#pragma unroll
        for (int kb = 0; kb < 8; ++kb)
#pragma unroll
            for (int j = 0; j < 4; ++j) so[(16 * kb + 4 * fq + j) * 128 + 16 * wid + fr] = S[kb][j]; }
}

#define XB_TMO      128
#define XB_XCNT(j)  (256  + 64 * (j))
#define XB_XSUB(j)  (1280 + 64 * (j))
#define XB_XGEN(j)  (2304 + 64 * (j))
#define XB_TOP      3328
#define XB_TOPGEN   3392
#define XCD_BAR_WORDS 3456
#define XB_SPIN_CAP (1u << 18)

__device__ __forceinline__ unsigned xb_ld(unsigned* p)              { return __hip_atomic_load(p, __ATOMIC_RELAXED, __HIP_MEMORY_SCOPE_AGENT); }
__device__ __forceinline__ unsigned xb_add(unsigned* p, unsigned v) { return __hip_atomic_fetch_add(p, v, __ATOMIC_RELAXED, __HIP_MEMORY_SCOPE_AGENT); }
__device__ __forceinline__ unsigned xb_xcc_id() { return (unsigned)__builtin_amdgcn_s_getreg((3 << 11) | 20) & 0xFu; }
#define XB_SPIN(cond, bar) do { unsigned _sp = 0; while (cond) { __builtin_amdgcn_s_sleep(1); \
    if ((++_sp & 255u) == 0u) { if (xb_ld(&(bar)[XB_TMO])) break; if (_sp > XB_SPIN_CAP) { atomicAdd(&(bar)[XB_TMO], 1u); break; } } } } while (0)

struct XcdBarrier {
    unsigned* bar; unsigned x;
    volatile LAS unsigned* st;
};

__device__ __forceinline__ XcdBarrier xcd_barrier_post(unsigned* bar, volatile LAS unsigned* st) {
    XcdBarrier b; b.bar = bar; b.x = xb_xcc_id(); b.st = st;
    if (threadIdx.x == 0) st[2] = xb_add(&bar[XB_XCNT(b.x)], 1u);
    return b;
}
__device__ __forceinline__ void xcd_barrier_complete(unsigned* bar, unsigned x, unsigned& nloc, unsigned& nx) {
    const unsigned G = gridDim.x * gridDim.y * gridDim.z;
    unsigned sum, cnt, mine, sp = 0u;
    for (;;) {
        sum = 0u; cnt = 0u; mine = 0u;
#pragma unroll
        for (unsigned j = 0; j < 16; ++j) { const unsigned c = xb_ld(&bar[XB_XCNT(j)]); sum += c; cnt += (c > 0u) ? 1u : 0u; mine = (j == x) ? c : mine; }
        if (sum == G) break;
        __builtin_amdgcn_s_sleep(1);
        if ((++sp & 255u) == 0u) { if (xb_ld(&bar[XB_TMO])) break; if (sp > XB_SPIN_CAP) { atomicAdd(&bar[XB_TMO], 1u); break; } }
    }
    nloc = mine > 0u ? mine : 1u; nx = cnt > 0u ? cnt : 1u;
}

__device__ __forceinline__ void xcd_barrier(const XcdBarrier& b) {
    asm volatile("s_waitcnt vmcnt(0)" ::: "memory");
    __syncthreads();
    if (threadIdx.x == 0) {
        unsigned* bar = b.bar;
        __builtin_amdgcn_s_waitcnt(0);
        unsigned nloc = b.st[0], nx = b.st[1];
        if (nloc == 0u) { xcd_barrier_complete(bar, b.x, nloc, nx); b.st[0] = nloc; b.st[1] = nx; }
        const unsigned old = xb_add(&bar[XB_XSUB(b.x)], 1u);
        const unsigned gen = old / nloc;
        if (old + 1u == (gen + 1u) * nloc) {
            __builtin_amdgcn_fence(__ATOMIC_RELEASE, "agent");
            asm volatile("s_waitcnt vmcnt(0)" ::: "memory");
            const unsigned og = xb_add(&bar[XB_TOP], 1u);
            const unsigned tg = og / nx;
            if (og + 1u == (tg + 1u) * nx) xb_add(&bar[XB_TOPGEN], 1u);
            else XB_SPIN(xb_ld(&bar[XB_TOPGEN]) == tg, bar);
            __builtin_amdgcn_fence(__ATOMIC_ACQUIRE, "agent");
            xb_add(&bar[XB_XGEN(b.x)], 1u);
            asm volatile("s_waitcnt vmcnt(0)" ::: "memory");
        } else {
            XB_SPIN(xb_ld(&bar[XB_XGEN(b.x)]) == gen, bar);
            __builtin_amdgcn_fence(__ATOMIC_ACQUIRE, "agent");
            asm volatile("s_waitcnt vmcnt(0)" ::: "memory");
        }
    }
    __syncthreads();
}

template <int ACT>
__device__ __forceinline__ void run_gemm(LAS unsigned char* lds, const bf16_t* A, const bf16_t* Bt, int N, int K, bf16_t* O, int ldc, const float* aux = nullptr) {
    const int vc = (int)((volatile LAS unsigned*)(lds + LDS_BYTES - 16))[3];
    pg8::Gemm g{A, Bt, NT, N, K}; pg8::StaticOrder S; S.init(NT, N, (int)gridDim.x, vc);
    pg8::EpiBf16<ACT> E{O, ldc, aux};
    pg8::gemm_phase<pg8::EpiBf16<ACT>, pg8::StaticOrder, true, true>(lds, g, S, E);
    if (PROBE_GEMM2) { __syncthreads(); pg8::gemm_phase<pg8::EpiBf16<ACT>, pg8::StaticOrder, true, true>(lds, g, S, E); }
}

__global__ void __launch_bounds__(NTHREADS, 2) fwd_megakernel(Params Pval) {
    extern __shared__ __attribute__((aligned(16))) unsigned char lds_raw[];
    LAS unsigned char* lds = (LAS unsigned char*)lds_raw;
    cg::grid_group grid = cg::this_grid();
    CPP Pk = (CPP)__builtin_amdgcn_kernarg_segment_ptr();
    if (threadIdx.x < 4) ((LAS unsigned*)(lds + LDS_BYTES - 16))[threadIdx.x] = 0u;
    __syncthreads();
    const XcdBarrier xbar = xcd_barrier_post((unsigned*)(Pval.ws + WS_BAR), (volatile LAS unsigned*)(lds + LDS_BYTES - 16));
#define PH_BEGIN CPP P = Pk; FRESH(P); int tid_ = threadIdx.x; asm volatile("" : "+v"(tid_)); const int tid = tid_, lane = tid & 63, wave = __builtin_amdgcn_readfirstlane(tid >> 6); const int G = gridDim.x, bid = blockIdx.x, gw = bid * 8 + wave, ngw = G * 8; \
    unsigned char* ws = P->ws; float* X = P->out; float* mod = (float*)(ws + WS_MOD); const float* norm_g = P->in[8]; LAS float* scr = (LAS float*)(lds + 65536 + wave * 8448); \
    (void)lane; (void)gw; (void)ngw; (void)X; (void)mod; (void)norm_g; (void)scr; (void)bid; (void)G;
#define W1_0 ((bf16_t*)(P->out + OUT_SH))
#define W2_0 (W1_0 + (size_t)4096 * 1024)
#define WGIN ((bf16_t*)(ws + WS_170))
#define WOUT0 ((bf16_t*)(ws + WS_WOUT0))
#define WOUT1 ((bf16_t*)(ws + WS_WOUT1))
    { PH_BEGIN
      for (int it = bid; it < 192; it += G) mod_item(P, lds, it);
      convert_matrix(P->in[9], 1024, 4128, WGIN, scr, gw, ngw, lane);
      for (int i = bid * NTHREADS + tid; i < 224 * 1024 / 8; i += G * NTHREADS) *(u32x4*)(WGIN + (size_t)4128 * 1024 + (size_t)i * 8) = (u32x4){0u, 0u, 0u, 0u};
 }
    if (Pval.ws == nullptr) grid.sync();
    xcd_barrier(xbar); if (PROBE_SYNC2) xcd_barrier(xbar);
    { volatile LAS unsigned* ctl = (volatile LAS unsigned*)(lds + LDS_BYTES - 16);
      if (threadIdx.x == 0) { unsigned* bar = (unsigned*)(Pval.ws + WS_BAR); const unsigned Gn = gridDim.x; bool ok = (Gn % 8u) == 0u; unsigned npop = 0u;
#pragma unroll
          for (unsigned j = 0; j < 16; ++j) { const unsigned cnt = xb_ld(&bar[XB_XCNT(j)]); if (j < 8) { ok = ok && (cnt == Gn / 8u); npop += (cnt > 0u) ? 1u : 0u; } else ok = ok && (cnt == 0u); }
          ok = ok && (npop == 8u) && (xbar.x < 8u) && (ctl[2] < Gn / 8u);
          ctl[3] = ok ? (xbar.x + 8u * ctl[2]) : (unsigned)blockIdx.x; }
      __syncthreads(); }
    { PH_BEGIN EwArgs A{P->in[0], P->in[1], nullptr, 0, 0, nullptr, 0, nullptr, nullptr, 0, norm_g + 0 * 1024, mod, 1024, 0, (bf16_t*)(ws + WS_210)}; ew_phase<0, 0>(A, gw, ngw, lane); }
    xcd_barrier(xbar); if (PROBE_SYNC2) xcd_barrier(xbar);
    { PH_BEGIN run_gemm<3>(lds, (const bf16_t*)(ws + WS_210), WGIN, LD0, 1024, (bf16_t*)(ws + WS_BIG), LD0); }
    xcd_barrier(xbar); if (PROBE_SYNC2) xcd_barrier(xbar);
    { PH_BEGIN for (int u = bid, k = 0; u < 2048; u += G, ++k) conv_unit(lds, P, u, k == 0 || (G & 7) != 0); }
    xcd_barrier(xbar);
    { PH_BEGIN for (int rnd = 0;; ++rnd) { const int it = scan_item_of(rnd, bid, G); if (it < 0) break; gdn_item(lds, P, it); BLOCK_SYNC(); if (PROBE_GDN2) { gdn_item(lds, P, it); BLOCK_SYNC(); } }
      { const bool half = (G == 256); const int cgw = half ? gw - 128 * 8 : gw, cngw = half ? 128 * 8 : ngw;
        if (cgw >= 0) { convert_matrix(P->in[14], 1024, 1024, WOUT0, scr, cgw, cngw, lane); convert_matrix(P->in[18], 1024, 1024, WOUT1, scr, cgw, cngw, lane);
                        convert_matrix(P->in[19], 1024, 4096, W1_0, scr, cgw, cngw, lane); convert_matrix(P->in[20], 4096, 1024, W2_0, scr, cgw, cngw, lane); } } }
    xcd_barrier(xbar); if (PROBE_SYNC2) xcd_barrier(xbar);
    { PH_BEGIN gate_phase((const bf16_t*)(ws + WS_170), DM, (const bf16_t*)(ws + WS_210), DM, (const bf16_t*)(ws + WS_BIG) + 3072, LD0, P->in[13], (bf16_t*)(ws + WS_170), gw, ngw, lane); }
    xcd_barrier(xbar); if (PROBE_SYNC2) xcd_barrier(xbar);
    { PH_BEGIN run_gemm<0>(lds, (const bf16_t*)(ws + WS_170), WOUT0, 1024, 1024, (bf16_t*)(ws + WS_210), DM); }
    xcd_barrier(xbar); if (PROBE_SYNC2) xcd_barrier(xbar);
    { PH_BEGIN EwArgs A{P->in[0], P->in[1], X, 0, 1, (const bf16_t*)(ws + WS_210), DM, norm_g + 1 * 1024, mod, 2048, norm_g + 2 * 1024, mod, 4096, 3072, (bf16_t*)(ws + WS_170)}; ew_phase<0, 1>(A, gw, ngw, lane); }
    xcd_barrier(xbar); if (PROBE_SYNC2) xcd_barrier(xbar);
    { PH_BEGIN run_gemm<2>(lds, (const bf16_t*)(ws + WS_170), W1_0, 4096, 1024, (bf16_t*)(ws + WS_BIG), 4096); }
    xcd_barrier(xbar); if (PROBE_SYNC2) xcd_barrier(xbar);
    { PH_BEGIN run_gemm<0>(lds, (const bf16_t*)(ws + WS_BIG), W2_0, 1024, 4096, (bf16_t*)(ws + WS_160), DM); }
    xcd_barrier(xbar); if (PROBE_SYNC2) xcd_barrier(xbar);
    { PH_BEGIN EwArgs A{nullptr, nullptr, X, 1, 1, (const bf16_t*)(ws + WS_160), DM, norm_g + 3 * 1024, mod, 5120, norm_g + 4 * 1024, mod + 9 * 6144, 1024, 0, (bf16_t*)(ws + WS_200)}; ew_phase<1, 1>(A, gw, ngw, lane);
      convert_matrix(P->in[15], 1024, 5120, (bf16_t*)(ws + WS_240), scr, gw, ngw, lane); }
    xcd_barrier(xbar); if (PROBE_SYNC2) xcd_barrier(xbar);
    { PH_BEGIN run_gemm<4>(lds, (const bf16_t*)(ws + WS_200), (const bf16_t*)(ws + WS_240), LD1, 1024, (bf16_t*)(ws + WS_BIG), LD1, P->in[16]); }
    xcd_barrier(xbar); if (PROBE_SYNC2) xcd_barrier(xbar);
    { PH_BEGIN for (int rnd = 0;; ++rnd) { const int it = scan_item_of(rnd, bid, G); if (it < 0) break; if (PROBE_HGRN2) { hgrn_item<true>(lds, P, it); BLOCK_SYNC(); } hgrn_item<false>(lds, P, it); BLOCK_SYNC(); } }
    xcd_barrier(xbar); if (PROBE_SYNC2) xcd_barrier(xbar);
    { PH_BEGIN gate_phase((const bf16_t*)(ws + WS_BIG) + 1024, LD1, (const bf16_t*)(ws + WS_BIG) + 2048, LD1, (const bf16_t*)(ws + WS_BIG) + 4096, LD1, P->in[17], (bf16_t*)(ws + WS_200), gw, ngw, lane); }
    xcd_barrier(xbar); if (PROBE_SYNC2) xcd_barrier(xbar);
    { PH_BEGIN run_gemm<0>(lds, (const bf16_t*)(ws + WS_200), WOUT1, 1024, 1024, (bf16_t*)(ws + WS_BIG), DM); }
    xcd_barrier(xbar); if (PROBE_SYNC2) xcd_barrier(xbar);
    { PH_BEGIN EwArgs A{nullptr, nullptr, X, 1, 1, (const bf16_t*)(ws + WS_BIG), DM, norm_g + 5 * 1024, mod + 9 * 6144, 2048, norm_g + 6 * 1024, mod + 9 * 6144, 4096, 3072, (bf16_t*)(ws + WS_200)}; ew_phase<1, 1>(A, gw, ngw, lane);
      convert_matrix(P->in[19] + (size_t)1024 * 4096, 1024, 4096, (bf16_t*)(ws + WS_168), scr, gw, ngw, lane);
      convert_matrix(P->in[20] + (size_t)4096 * 1024, 4096, 1024, (bf16_t*)(ws + WS_160), scr, gw, ngw, lane); }
    xcd_barrier(xbar); if (PROBE_SYNC2) xcd_barrier(xbar);
    { PH_BEGIN run_gemm<2>(lds, (const bf16_t*)(ws + WS_200), (const bf16_t*)(ws + WS_168), 4096, 1024, (bf16_t*)(ws + WS_BIG), 4096); }
    xcd_barrier(xbar); if (PROBE_SYNC2) xcd_barrier(xbar);
    { PH_BEGIN run_gemm<0>(lds, (const bf16_t*)(ws + WS_BIG), (const bf16_t*)(ws + WS_160), 1024, 4096, (bf16_t*)(ws + WS_200), DM); }
    xcd_barrier(xbar); if (PROBE_SYNC2) xcd_barrier(xbar);
    { PH_BEGIN EwArgs A{nullptr, nullptr, X, 1, 0, (const bf16_t*)(ws + WS_200), DM, norm_g + 7 * 1024, mod + 9 * 6144, 5120, nullptr, nullptr, 0, 0, nullptr}; ew_phase<1, 2>(A, gw, ngw, lane); }
}

extern "C" void kernel_launch(void* const* d_in, const int* in_sizes, int n_in, void* d_out, int out_size, void* d_ws, size_t ws_size, hipStream_t stream) {
    static int grid = 0;
    if (grid == 0) {
        if (n_in != 21 || ws_size < WS_NEED) { fprintf(stderr, "kernel_launch: need 21 inputs and >= %zu bytes of workspace (got %d, %zu)\n", (size_t)WS_NEED, n_in, ws_size); grid = -1; return; }
        int dev = 0, cus = 0, per_cu = 0;
        hipGetDevice(&dev); hipDeviceGetAttribute(&cus, hipDeviceAttributeMultiprocessorCount, dev);
        hipFuncSetAttribute((const void*)fwd_megakernel, hipFuncAttributeMaxDynamicSharedMemorySize, LDS_BYTES);
        hipOccupancyMaxActiveBlocksPerMultiprocessor(&per_cu, (const void*)fwd_megakernel, NTHREADS, LDS_BYTES);
        if (per_cu < 1) { fprintf(stderr, "kernel_launch: occupancy query reports %d blocks per CU\n", per_cu); per_cu = 1; }
        grid = cus * 1;
        (void)hipGetLastError();
    }
    if (grid < 0) return;
    Params p{};
    for (int i = 0; i < 21; ++i) p.in[i] = (const float*)d_in[i];
    p.out = (float*)d_out; p.ws = (unsigned char*)d_ws;
    if (hipMemsetAsync((char*)d_ws + WS_BAR, 0, BAR_BYTES, stream) != hipSuccess) { fprintf(stderr, "kernel_launch: memset of barrier words failed\n"); return; }
    void* args[] = {&p};
    hipError_t e = hipLaunchCooperativeKernel((const void*)fwd_megakernel, dim3(grid), dim3(NTHREADS), args, LDS_BYTES, stream);
    if (e != hipSuccess) fprintf(stderr, "cooperative launch failed: %s (grid %d)\n", hipGetErrorString(e), grid);
}
```

```cpp
#include <hip/hip_runtime.h>
#include <hip/hip_cooperative_groups.h>
#include <cstdio>
#include <cstdint>
namespace cg = cooperative_groups;
#ifndef PROBE_GEMM2
#define PROBE_GEMM2 0
#endif
#ifndef PROBE_GDN2
#define PROBE_GDN2 0
#endif
#ifndef PROBE_HGRN2
#define PROBE_HGRN2 0
#endif
#ifndef PROBE_GCONV2
#define PROBE_GCONV2 0
#endif
#ifndef PROBE_GSOLVE2
#define PROBE_GSOLVE2 0
#endif
#ifndef PROBE_SYNC2
#define PROBE_SYNC2 0
#endif
namespace pg8 {
#define PG8_LAS __attribute__((address_space(3)))
typedef unsigned short bf16_t;
typedef short bf16x8 __attribute__((ext_vector_type(8)));
typedef float f32x4 __attribute__((ext_vector_type(4)));
typedef unsigned u32x4 __attribute__((ext_vector_type(4)));
constexpr int BM = 256, BK = 64, HALF = 128, HTB = HALF * BK * 2  , STAGE_BYTES = 8 * HTB, NXCD = 8, WGM = 8;

__host__ __device__ __forceinline__ int lds_byte(int r, int c) { const int st = (r >> 4) * 2 + (c >> 5), rr = r & 15, cc = c & 31, ob = rr * 64 + cc * 2; return st * 1024 + (ob ^ (((ob >> 9) & 1) << 5)); }
__host__ __device__ __forceinline__ void stage_rc(int b, int& R, int& C) { const int st = b / 1024, sb = b % 1024, swz = sb ^ (((sb >> 9) & 1) << 5); R = (st >> 1) * 16 + swz / 64; C = (st & 1) * 32 + (swz % 64) / 2; }
__host__ __device__ __forceinline__ int perm32(int rho) { const int n = rho >> 4, i = rho & 15; return 8 * (i >> 2) + 4 * n + (i & 3); }

struct Unit { int pm, pn; };
struct Gemm { const bf16_t* A; const bf16_t* Bt; int M, N, K; };

struct StaticOrder {
    int nM, nN, nwg, G, c;
    __host__ __device__ void init(int M, int N, int G_, int c_) { nM = M / BM; nN = N / BM; nwg = nM * nN; G = G_; c = c_; }
    __host__ __device__ bool next(int i, Unit& u) const {
        const long L = (long)i * G + c; if (L >= nwg) return false;
        int wgid = (int)L; { const int q = nwg / NXCD, r = nwg % NXCD, xcd = wgid % NXCD, off = wgid / NXCD; wgid = (xcd < r ? xcd * (q + 1) : r * (q + 1) + (xcd - r) * q) + off; }
        if (nN == 4) { u.pm = wgid >> 2; u.pn = wgid & 3; return true; }
        const int nig = WGM * nN, gid = wgid / nig, fm = gid * WGM, gsz = (nM - fm) < WGM ? (nM - fm) : WGM;
        u.pm = fm + ((wgid % nig) % gsz); u.pn = (wgid % nig) / gsz; return true;
    }
    __device__ __forceinline__ void a_ready(const Unit&) const {}
    __device__ __forceinline__ void done(const Unit&) const {}
};

typedef __bf16 b16x2v __attribute__((ext_vector_type(2)));
typedef float f32x2 __attribute__((ext_vector_type(2)));
__device__ __forceinline__ unsigned cvt_pk_bf16(float lo, float hi) { f32x2 v = {lo, hi}; b16x2v r = __builtin_convertvector(v, b16x2v); return __builtin_bit_cast(unsigned, r); }
template <int ACT  > struct EpiBf16 {
    static constexpr bool PERM = true, AFTER_DRAIN = false;
    bf16_t* O; int ldc; const float* aux;
    __device__ __forceinline__ static float silu1(float x) { return x * __builtin_amdgcn_rcpf(1.f + __expf(-x)); }
    __device__ __forceinline__ void operator()(const f32x4 (&acc)[2][2][4][2], const Unit& u, int wr, int wc, int fr, int fq) const {
        const int row0 = u.pm * BM + wr * 64 + fr; const int col0 = u.pn * BM + wc * 32 + 8 * fq;
        const bool do_silu = (ACT == 3) ? (u.pn >= 12 && u.pn < 16) : (ACT == 4) ? (u.pn < 4 || u.pn >= 16) : false;
        const bool do_logf = (ACT == 4) && (u.pn >= 4 && u.pn < 12);
        float lb[2][8];
        if (ACT == 4) { if (do_logf) {
#pragma unroll
            for (int bj = 0; bj < 2; ++bj)
#pragma unroll
                for (int e = 0; e < 8; ++e) { const int k = col0 + bj * HALF + e - 1024; lb[bj][e] = __builtin_amdgcn_rcpf(1.f + __expf(aux[k] - aux[2048 + k])); } } }
#pragma unroll
        for (int ai = 0; ai < 2; ++ai)
#pragma unroll
            for (int m = 0; m < 4; ++m) { bf16_t* rowp = O + (size_t)(row0 + ai * HALF + m * 16) * ldc + col0;
#pragma unroll
                for (int bj = 0; bj < 2; ++bj) { f32x4 v0 = acc[ai][bj][m][0], v1 = acc[ai][bj][m][1];
                    if (ACT == 2) {
#pragma unroll
                        for (int e = 0; e < 4; ++e) { const float a = v0[e] > 0.f ? v0[e] : 0.f, b = v1[e] > 0.f ? v1[e] : 0.f; v0[e] = a * a; v1[e] = b * b; } }
                    if (ACT == 3 || ACT == 4) { if (do_silu) {
#pragma unroll
                        for (int e = 0; e < 4; ++e) { v0[e] = silu1(v0[e]); v1[e] = silu1(v1[e]); } } }
                    if (ACT == 4) { if (do_logf) {
#pragma unroll
                        for (int e = 0; e < 4; ++e) { const float l0 = lb[bj][e], l1 = lb[bj][4 + e];
                            v0[e] = l0 + (1.f - l0) * __builtin_amdgcn_rcpf(1.f + __expf(-v0[e])); v1[e] = l1 + (1.f - l1) * __builtin_amdgcn_rcpf(1.f + __expf(-v1[e])); } } }
                    u32x4 w; w.x = cvt_pk_bf16(v0[0], v0[1]); w.y = cvt_pk_bf16(v0[2], v0[3]); w.z = cvt_pk_bf16(v1[0], v1[1]); w.w = cvt_pk_bf16(v1[2], v1[3]);
                    *(u32x4*)(rowp + bj * HALF) = w; } }
    }
};

template <class Epi, class Sched, bool ALIGN_EPI = false, bool SP2 = false>
__device__ __forceinline__ void gemm_phase(PG8_LAS unsigned char* lds, const Gemm g, const Sched& S, const Epi& E) {
    int tid_ = threadIdx.x; asm volatile("" : "+v"(tid_));
    const int tid = tid_, wid = __builtin_amdgcn_readfirstlane(tid >> 6), lane = tid & 63, wr = wid >> 2, wc = wid & 3, fr = lane & 15, fq = lane >> 4;
    const int K = g.K, nt = K / BK;
    unsigned voffA[2], voffB[2];
#pragma unroll
    for (int i = 0; i < 2; ++i) { int R, C; stage_rc(tid * 16 + i * 8192, R, C); const int Rb = Epi::PERM ? ((R & ~31) + perm32(R & 31)) : R;
        voffA[i] = (unsigned)(R * K + C) * 2u; voffB[i] = (unsigned)(Rb * K + C) * 2u; }
    const size_t kstep = (size_t)(BK * 2);
    const size_t hstep = (size_t)HALF * K * 2;
    const size_t tstep = 2 * hstep;
    const unsigned ldsw = (unsigned)wid * 1024u;
    const int aoff = lds_byte(wr * 64 + fr, fq * 8), boff = lds_byte(wc * 32 + fr, fq * 8);
#define PG8_SA(b, h) (((b) * 2 + (h)) * HTB)
#define PG8_SB(b, h) ((4 + (b) * 2 + (h)) * HTB)
#define PG8_STAGE(bufoff, gbase, voff) do { _Pragma("unroll") for (int _i = 0; _i < 2; ++_i) \
        __builtin_amdgcn_global_load_lds((const unsigned*)((const char*)(gbase) + (voff)[_i]), (PG8_LAS unsigned*)(lds + (bufoff) + ldsw + _i * 8192), 16, 0, 0); } while (0)
#define PG8_LDA(dst, b, h) do { _Pragma("unroll") for (int m = 0; m < 4; ++m) _Pragma("unroll") for (int k = 0; k < 2; ++k) dst[m][k] = *(const PG8_LAS bf16x8*)(lds + PG8_SA(b, h) + aoff + m * 2048 + k * 1024); } while (0)
#define PG8_LDB(dst, b, h) do { _Pragma("unroll") for (int n = 0; n < 2; ++n) _Pragma("unroll") for (int k = 0; k < 2; ++k) dst[n][k] = *(const PG8_LAS bf16x8*)(lds + PG8_SB(b, h) + boff + n * 2048 + k * 1024); } while (0)
#define PG8_MMA(ai, bj, At, Bt) do { __builtin_amdgcn_s_setprio(1); _Pragma("unroll") for (int m = 0; m < 4; ++m) _Pragma("unroll") for (int n = 0; n < 2; ++n) _Pragma("unroll") for (int k = 0; k < 2; ++k) \
        acc[ai][bj][m][n] = __builtin_amdgcn_mfma_f32_16x16x32_bf16(Bt[n][k], At[m][k], acc[ai][bj][m][n], 0, 0, 0); __builtin_amdgcn_s_setprio(0); } while (0)
#define PG8_WAIT_V(n) asm volatile("s_waitcnt vmcnt(" #n ")" ::: "memory")
#define PG8_WAIT_L(n) asm volatile("s_waitcnt lgkmcnt(" #n ")" ::: "memory")
#define PG8_BAR __builtin_amdgcn_s_barrier()
#define PG8_SCHED __builtin_amdgcn_sched_barrier(0)
    Unit cur, nxt; int ui = 0;
    if (!S.next(0, cur)) return;
    f32x4 acc[2][2][4][2];
#pragma unroll
    for (int a = 0; a < 2; ++a)
#pragma unroll
        for (int b = 0; b < 2; ++b)
#pragma unroll
            for (int m = 0; m < 4; ++m)
#pragma unroll
                for (int n = 0; n < 2; ++n) acc[a][b][m][n] = (f32x4){0.f, 0.f, 0.f, 0.f};
    bf16x8 At[4][2], B0[2][2], B1[2][2];
    const char* cA = (const char*)g.A + (size_t)cur.pm * tstep; const char* cB = (const char*)g.Bt + (size_t)cur.pn * tstep;
    S.a_ready(cur);
    if constexpr (SP2) {
        PG8_STAGE(PG8_SB(0, 0), cB, voffB); PG8_STAGE(PG8_SB(0, 1), cB + hstep, voffB); PG8_STAGE(PG8_SA(0, 0), cA, voffA); PG8_STAGE(PG8_SA(0, 1), cA + hstep, voffA);
        if (wr == 1) PG8_BAR;
        PG8_WAIT_V(2); PG8_BAR;
        PG8_STAGE(PG8_SB(1, 0), cB + kstep, voffB); PG8_STAGE(PG8_SA(1, 0), cA + kstep, voffA); PG8_STAGE(PG8_SB(1, 1), cB + hstep + kstep, voffB);
        PG8_WAIT_V(6); PG8_BAR;
    } else {
        PG8_STAGE(PG8_SB(0, 0), cB, voffB); PG8_STAGE(PG8_SA(0, 0), cA, voffA); PG8_STAGE(PG8_SB(0, 1), cB + hstep, voffB); PG8_STAGE(PG8_SA(0, 1), cA + hstep, voffA);
        if (wr == 1) PG8_BAR;
        PG8_WAIT_V(4); PG8_BAR;
        PG8_STAGE(PG8_SB(1, 0), cB + kstep, voffB); PG8_STAGE(PG8_SA(1, 0), cA + kstep, voffA); PG8_STAGE(PG8_SB(1, 1), cB + hstep + kstep, voffB);
        PG8_WAIT_V(6); PG8_BAR;
    }
    for (;;) {
        const bool has_next = S.next(ui + 1, nxt);
        const char* nA = has_next ? (const char*)g.A + (size_t)nxt.pm * tstep : cA; const char* nB = has_next ? (const char*)g.Bt + (size_t)nxt.pn * tstep : cB;
        for (int t = 0; t < nt; t += 2) {
            const bool last = (t == nt - 2);
            const char* a1 = cA + (size_t)(t + 1) * kstep;
            const char* a2 = last ? nA : cA + (size_t)(t + 2) * kstep; const char* b2 = last ? nB : cB + (size_t)(t + 2) * kstep;
            const char* a3 = a2 + kstep; const char* b3 = b2 + kstep;
            if (last && has_next) S.a_ready(nxt);
            if constexpr (SP2) {
            PG8_LDB(B0, 0, 0); PG8_LDB(B1, 0, 1); PG8_SCHED; PG8_LDA(At, 0, 0); PG8_STAGE(PG8_SA(1, 1), a1 + hstep, voffA);
            PG8_WAIT_V(8); PG8_WAIT_L(0); PG8_BAR; PG8_MMA(0, 0, At, B0); PG8_MMA(0, 1, At, B1); PG8_BAR; PG8_SCHED;
            PG8_LDA(At, 0, 1); PG8_STAGE(PG8_SB(0, 0), b2, voffB); PG8_STAGE(PG8_SB(0, 1), b2 + hstep, voffB); PG8_STAGE(PG8_SA(0, 0), a2, voffA);
            PG8_WAIT_V(8); PG8_WAIT_L(0); PG8_BAR; PG8_MMA(1, 0, At, B0); PG8_MMA(1, 1, At, B1); PG8_BAR; PG8_SCHED;
            PG8_LDB(B0, 1, 0); PG8_LDB(B1, 1, 1); PG8_SCHED; PG8_LDA(At, 1, 0); PG8_STAGE(PG8_SA(0, 1), a2 + hstep, voffA);
            PG8_WAIT_V(8); PG8_WAIT_L(0); PG8_BAR; PG8_MMA(0, 0, At, B0); PG8_MMA(0, 1, At, B1); PG8_BAR; PG8_SCHED;
            PG8_LDA(At, 1, 1); PG8_STAGE(PG8_SB(1, 0), b3, voffB); PG8_STAGE(PG8_SB(1, 1), b3 + hstep, voffB); PG8_STAGE(PG8_SA(1, 0), a3, voffA);
            PG8_WAIT_V(8); PG8_WAIT_L(0); PG8_BAR; PG8_MMA(1, 0, At, B0); PG8_MMA(1, 1, At, B1); PG8_BAR; PG8_SCHED;
            } else {
            PG8_LDB(B0, 0, 0); PG8_SCHED; PG8_LDA(At, 0, 0); PG8_STAGE(PG8_SA(1, 1), a1 + hstep, voffA);
            PG8_WAIT_L(8); PG8_BAR; PG8_WAIT_L(0); PG8_MMA(0, 0, At, B0); PG8_BAR; PG8_SCHED;
            PG8_LDB(B1, 0, 1); PG8_STAGE(PG8_SB(0, 0), b2, voffB);
            PG8_BAR; PG8_WAIT_L(0); PG8_MMA(0, 1, At, B1); PG8_BAR;
            PG8_LDA(At, 0, 1); PG8_STAGE(PG8_SA(0, 0), a2, voffA);
            PG8_BAR; PG8_WAIT_L(0); PG8_MMA(1, 0, At, B0); PG8_BAR; PG8_SCHED;
            PG8_STAGE(PG8_SB(0, 1), b2 + hstep, voffB);
            PG8_WAIT_V(6); PG8_BAR; PG8_MMA(1, 1, At, B1); PG8_BAR;
            PG8_LDB(B0, 1, 0); PG8_SCHED; PG8_LDA(At, 1, 0); PG8_STAGE(PG8_SA(0, 1), a2 + hstep, voffA);
            PG8_WAIT_L(8); PG8_BAR; PG8_WAIT_L(0); PG8_MMA(0, 0, At, B0); PG8_BAR; PG8_SCHED;
            PG8_LDB(B1, 1, 1); PG8_STAGE(PG8_SB(1, 0), b3, voffB);
            PG8_BAR; PG8_WAIT_L(0); PG8_MMA(0, 1, At, B1); PG8_BAR;
            PG8_LDA(At, 1, 1); PG8_STAGE(PG8_SA(1, 0), a3, voffA);
            PG8_BAR; PG8_WAIT_L(0); PG8_MMA(1, 0, At, B0); PG8_BAR; PG8_SCHED;
            PG8_STAGE(PG8_SB(1, 1), b3 + hstep, voffB);
            PG8_WAIT_V(6); PG8_BAR; PG8_MMA(1, 1, At, B1); PG8_BAR;
            }
        }
        if constexpr (ALIGN_EPI) { if (wr == 0) PG8_BAR; }
        if constexpr (!Epi::AFTER_DRAIN) { E(acc, cur, wr, wc, fr, fq); S.done(cur); }
        if (!has_next) break;
#pragma unroll
        for (int a = 0; a < 2; ++a)
#pragma unroll
            for (int b = 0; b < 2; ++b)
#pragma unroll
                for (int m = 0; m < 4; ++m)
#pragma unroll
                    for (int n = 0; n < 2; ++n) acc[a][b][m][n] = (f32x4){0.f, 0.f, 0.f, 0.f};
        cur = nxt; cA = nA; cB = nB; ++ui;
        if constexpr (ALIGN_EPI) { if (wr == 1) PG8_BAR; }
    }
    PG8_WAIT_V(0);
    if constexpr (!ALIGN_EPI) { if (wr == 0) PG8_BAR; }
    PG8_BAR;
    if constexpr (Epi::AFTER_DRAIN) { E.fused(acc, cur, wr, wc, fr, fq, lds, wid, lane); S.done(cur); }
#undef PG8_SA
#undef PG8_SB
#undef PG8_STAGE
#undef PG8_LDA
#undef PG8_LDB
#undef PG8_MMA
#undef PG8_WAIT_V
#undef PG8_WAIT_L
#undef PG8_BAR
#undef PG8_SCHED
}
}
#define LAS __attribute__((address_space(3)))
typedef unsigned short bf16_t;
typedef float f32x4 __attribute__((ext_vector_type(4)));
typedef float f32x2 __attribute__((ext_vector_type(2)));
typedef short s16x4 __attribute__((ext_vector_type(4)));
typedef short bf16x8 __attribute__((ext_vector_type(8)));
typedef unsigned u32x4 __attribute__((ext_vector_type(4)));
typedef unsigned u32x2 __attribute__((ext_vector_type(2)));
typedef __bf16 b16x2 __attribute__((ext_vector_type(2)));

constexpr int NT = 20480, NPR = 4096, DM = 1024, TS = 2048, TP = 256;
constexpr int LDS_BYTES = 151552;
constexpr int NTHREADS = 512;
constexpr size_t MiB = (size_t)1 << 20;
constexpr int LD0 = 4352, LD1 = 5120;
constexpr size_t WS_BIG = 0, WS_160 = 160 * MiB, WS_168 = 168 * MiB, WS_170 = 170 * MiB, WS_200 = 200 * MiB, WS_210 = 210 * MiB, WS_240 = 240 * MiB;
constexpr size_t WS_BAR = 255 * MiB, BAR_BYTES = 16384;
constexpr size_t WS_WOUT0 = 250 * MiB, WS_WOUT1 = 252 * MiB, WS_MOD = 254 * MiB, WS_NEED = 256 * MiB;
constexpr size_t OUT_SG = (size_t)NT * DM, OUT_SH = OUT_SG + (size_t)16 * 2 * 8 * 128 * 128;
constexpr float EPSF = 1e-6f;

struct Params { const float* in[21]; float* out; unsigned char* ws; };
typedef const __attribute__((address_space(4))) Params* CPP;
#define FRESH(q) asm volatile("" : "+s"(q))

__device__ __forceinline__ float bf2f(unsigned v) { return __uint_as_float(v << 16); }
__device__ __forceinline__ unsigned pk2(float lo, float hi) { f32x2 v = {lo, hi}; b16x2 r = __builtin_convertvector(v, b16x2); return __builtin_bit_cast(unsigned, r); }
__device__ __forceinline__ s16x4 pk4(f32x4 v) { u32x2 r; r.x = pk2(v[0], v[1]); r.y = pk2(v[2], v[3]); return __builtin_bit_cast(s16x4, r); }
__device__ __forceinline__ f32x4 unpk4(s16x4 v) { u32x2 r = __builtin_bit_cast(u32x2, v); f32x4 o; o[0] = __uint_as_float(r.x << 16); o[1] = __uint_as_float(r.x & 0xffff0000u); o[2] = __uint_as_float(r.y << 16); o[3] = __uint_as_float(r.y & 0xffff0000u); return o; }
__device__ __forceinline__ float silu_f(float x) { return x * __builtin_amdgcn_rcpf(1.f + __expf(-x)); }
__device__ __forceinline__ float sigmoid_f(float x) { return __builtin_amdgcn_rcpf(1.f + __expf(-x)); }
__device__ __forceinline__ f32x4 mfma16(s16x4 a, s16x4 b, f32x4 c) { return __builtin_amdgcn_mfma_f32_16x16x16bf16_1k(a, b, c, 0, 0, 0); }
__device__ __forceinline__ f32x4 mfma32(bf16x8 a, bf16x8 b, f32x4 c) { return __builtin_amdgcn_mfma_f32_16x16x32_bf16(a, b, c, 0, 0, 0); }
#define BLOCK_SYNC() __syncthreads()
#define LDS_SYNC() do { asm volatile("s_waitcnt lgkmcnt(0)" ::: "memory"); __builtin_amdgcn_s_barrier(); asm volatile("" ::: "memory"); } while (0)

__device__ __forceinline__ void transpose_item(const float* W, int K, int N, bf16_t* WT, LAS float* scr, int item, int lane) {
    const int nblk = N / 32, kb = item / nblk, nb = item % nblk, k0 = 64 * kb, n0 = 32 * nb;
#pragma unroll 8
    for (int i = 0; i < 32; ++i) { const int kk = 2 * i + (lane >> 5); scr[kk * 33 + (lane & 31)] = W[(size_t)(k0 + kk) * N + n0 + (lane & 31)]; }
    asm volatile("s_waitcnt lgkmcnt(0)" ::: "memory");
    const int c = lane & 7;
#pragma unroll
    for (int j = 0; j < 4; ++j) { const int n = (lane >> 3) + 8 * j; const LAS float* s = scr + (8 * c) * 33 + n;
        u32x4 o; o.x = pk2(s[0 * 33], s[1 * 33]); o.y = pk2(s[2 * 33], s[3 * 33]); o.z = pk2(s[4 * 33], s[5 * 33]); o.w = pk2(s[6 * 33], s[7 * 33]);
        *(u32x4*)(WT + (size_t)(n0 + n) * K + k0 + 8 * c) = o; }
    asm volatile("s_waitcnt lgkmcnt(0)" ::: "memory");
}
__device__ __forceinline__ void convert_matrix(const float* W, int K, int N, bf16_t* WT, LAS float* scr, int gw, int ngw, int lane) {
    const int nitems = (K / 64) * (N / 32);
    for (int it = gw; it < nitems; it += ngw) transpose_item(W, K, N, WT, scr, it, lane);
}

__device__ __forceinline__ void mod_item(CPP P, LAS unsigned char* lds, int item) {
    int tid_ = threadIdx.x; asm volatile("" : "+v"(tid_)); const int tid = tid_, lane = tid & 63, w = tid >> 6;
    const int layer = item / 96, cb = item % 96, n0 = cb * 64;
    LAS float* ca = (LAS float*)lds;
    LAS float* red = (LAS float*)(lds + 36864);
    const float* c = P->in[4]; const float* cctx = P->in[5];
    for (int i = tid; i < 9 * 1024; i += NTHREADS) { const float v = (i < 1024) ? cctx[i] : c[i - 1024]; ca[i] = silu_f(v); }
    BLOCK_SYNC();
    const float* wp = P->in[6] + (size_t)layer * 1024 * 6144 + n0 + lane;
    float acc[9];
#pragma unroll
    for (int r = 0; r < 9; ++r) acc[r] = 0.f;
#pragma unroll 8
    for (int k = 128 * w; k < 128 * w + 128; ++k) { const float wv = wp[(size_t)k * 6144];
#pragma unroll
        for (int r = 0; r < 9; ++r) acc[r] += ca[r * 1024 + k] * wv; }
#pragma unroll
    for (int r = 0; r < 9; ++r) red[(w * 9 + r) * 64 + lane] = acc[r];
    BLOCK_SYNC();
    float* mod = (float*)(P->ws + WS_MOD);
    for (int idx = tid; idx < 9 * 64; idx += NTHREADS) { const int r = idx >> 6, l = idx & 63; float s = 0.f;
#pragma unroll
        for (int ww = 0; ww < 8; ++ww) s += red[(ww * 9 + r) * 64 + l];
        mod[(size_t)(layer * 9 + r) * 6144 + n0 + l] = s + P->in[7][layer * 6144 + n0 + l]; }
    BLOCK_SYNC();
}

struct EwArgs { const float* xin_p; const float* xin_s; float* X; int xb_in, xb_out;
                const bf16_t* Y; int ldy; const float* gy; const float* mod_y; int gate_off;
                const float* gh; const float* mod_h; int sc_off, sh_off; bf16_t* H; };
__device__ __forceinline__ float wave_sum(float v) {
    int x_;
#define DPPADD(ctrl, rmask) do { x_ = __builtin_amdgcn_update_dpp(0, __float_as_int(v), (ctrl), (rmask), 0xf, false); v += __int_as_float(x_); } while (0)
    DPPADD(0x111, 0xf); DPPADD(0x112, 0xf); DPPADD(0x114, 0xf); DPPADD(0x118, 0xf); DPPADD(0x142, 0xa); DPPADD(0x143, 0xc);
#undef DPPADD
    return __int_as_float(__builtin_amdgcn_readlane(__float_as_int(v), 63));
}
template <int XIN  , int XOUT  >
__device__ __forceinline__ void ew_phase(const EwArgs& A, int gw, int ngw, int lane) {
    const int per = (NT + ngw - 1) / ngw; const int mbeg = gw * per, mend = (mbeg + per < NT) ? mbeg + per : NT;
    f32x4 gyv[4], ghv[4], gtv[4], scv[4], shv[4];
#pragma unroll
    for (int j = 0; j < 4; ++j) { gyv[j] = A.Y ? *(const f32x4*)(A.gy + 4 * lane + 256 * j) : (f32x4){0.f, 0.f, 0.f, 0.f}; ghv[j] = A.H ? *(const f32x4*)(A.gh + 4 * lane + 256 * j) : (f32x4){0.f, 0.f, 0.f, 0.f};
        gtv[j] = (f32x4){0.f, 0.f, 0.f, 0.f}; scv[j] = gtv[j]; shv[j] = gtv[j]; }
    f32x4 cxf[4], nxf[4]; u32x2 cxb[4], nxb[4], cy[4], ny[4];
#define EW_LOADROW(mm, xf, xbv, yv) do { const int m_ = (mm); \
        if (XIN == 1) { const bf16_t* xb_ = (const bf16_t*)A.X + (size_t)m_ * 2048 + 1024; _Pragma("unroll") for (int j = 0; j < 4; ++j) xbv[j] = *(const u32x2*)(xb_ + 4 * lane + 256 * j); } \
        else { const float* xr_ = (m_ < NPR) ? A.xin_p + (size_t)m_ * DM : A.xin_s + (size_t)(m_ - NPR) * DM; _Pragma("unroll") for (int j = 0; j < 4; ++j) xf[j] = *(const f32x4*)(xr_ + 4 * lane + 256 * j); } \
        if (A.Y) { _Pragma("unroll") for (int j = 0; j < 4; ++j) yv[j] = *(const u32x2*)(A.Y + (size_t)m_ * A.ldy + 4 * lane + 256 * j); } } while (0)
    if (mbeg < mend) EW_LOADROW(mbeg, cxf, cxb, cy);
    int rcur = -1;
    for (int m = mbeg; m < mend; ++m) {
        if (m + 1 < mend) EW_LOADROW(m + 1, nxf, nxb, ny);
        const int r = (m < NPR) ? 0 : 1 + ((m - NPR) >> 11);
        if (r != rcur) { rcur = r;
#pragma unroll
            for (int j = 0; j < 4; ++j) { if (A.Y) gtv[j] = *(const f32x4*)(A.mod_y + (size_t)r * 6144 + A.gate_off + 4 * lane + 256 * j);
                if (A.H) { scv[j] = *(const f32x4*)(A.mod_h + (size_t)r * 6144 + A.sc_off + 4 * lane + 256 * j); shv[j] = *(const f32x4*)(A.mod_h + (size_t)r * 6144 + A.sh_off + 4 * lane + 256 * j); } } }
        f32x4 x[4];
        bf16_t* xb = (XIN == 1 || XOUT == 1) ? (bf16_t*)A.X + (size_t)m * 2048 + 1024 : nullptr;
        if (XIN == 1) {
#pragma unroll
            for (int j = 0; j < 4; ++j) x[j] = unpk4(__builtin_bit_cast(s16x4, cxb[j])); }
        else {
#pragma unroll
            for (int j = 0; j < 4; ++j) x[j] = cxf[j]; }
        if (A.Y) {
            f32x4 y[4]; float ss = 0.f;
#pragma unroll
            for (int j = 0; j < 4; ++j) { y[j] = unpk4(__builtin_bit_cast(s16x4, cy[j]));
                ss += (y[j][0] * y[j][0] + y[j][1] * y[j][1]) + (y[j][2] * y[j][2] + y[j][3] * y[j][3]); }
            const float rstd = rsqrtf(wave_sum(ss) * (1.f / DM) + EPSF);
#pragma unroll
            for (int j = 0; j < 4; ++j) x[j] = x[j] + gtv[j] * (y[j] * rstd * gyv[j]);
        }
        if (XOUT == 1) {
#pragma unroll
            for (int j = 0; j < 4; ++j) { u32x2 o; o.x = pk2(x[j][0], x[j][1]); o.y = pk2(x[j][2], x[j][3]); *(u32x2*)(xb + 4 * lane + 256 * j) = o; } }
        else if (XOUT == 2) {
#pragma unroll
            for (int j = 0; j < 4; ++j) *(f32x4*)(A.X + (size_t)m * DM + 4 * lane + 256 * j) = x[j]; }
        if (A.H) {
            float ss = 0.f;
#pragma unroll
            for (int j = 0; j < 4; ++j) ss += (x[j][0] * x[j][0] + x[j][1] * x[j][1]) + (x[j][2] * x[j][2] + x[j][3] * x[j][3]);
            const float rstd = rsqrtf(wave_sum(ss) * (1.f / DM) + EPSF);
#pragma unroll
            for (int j = 0; j < 4; ++j) { const f32x4 h = (x[j] * rstd * ghv[j]) * (scv[j] + 1.f) + shv[j]; u32x2 o; o.x = pk2(h[0], h[1]); o.y = pk2(h[2], h[3]);
                *(u32x2*)(A.H + (size_t)m * DM + 4 * lane + 256 * j) = o; }
        }
#pragma unroll
        for (int j = 0; j < 4; ++j) { cxf[j] = nxf[j]; cxb[j] = nxb[j]; cy[j] = ny[j]; }
    }
#undef EW_LOADROW
}
__device__ __forceinline__ void gate_phase(const bf16_t* of, int ldf, const bf16_t* ob, int ldb, const bf16_t* z, int ldz, const float* g, bf16_t* out, int gw, int ngw, int lane) {
    const int cg0 = (16 * lane) & 127; float gv[16];
#pragma unroll
    for (int e = 0; e < 16; ++e) gv[e] = g[cg0 + e];
    u32x4 ca[2], cb[2], cc[2], na[2], nb[2], nc[2];
#define GT_LOADROW(mm, av, bv, cv) do { const int m_ = (mm); _Pragma("unroll") for (int hh = 0; hh < 2; ++hh) { av[hh] = *(const u32x4*)(of + (size_t)m_ * ldf + 16 * lane + 8 * hh); \
        bv[hh] = *(const u32x4*)(ob + (size_t)m_ * ldb + 16 * lane + 8 * hh); cv[hh] = *(const u32x4*)(z + (size_t)m_ * ldz + 16 * lane + 8 * hh); } } while (0)
    if (gw < NT) GT_LOADROW(gw, ca, cb, cc);
    for (int m = gw; m < NT; m += ngw) {
        if (m + ngw < NT) GT_LOADROW(m + ngw, na, nb, nc);
        float s[16], zz[16];
#pragma unroll
        for (int hh = 0; hh < 2; ++hh) {
            const u32x4 a = ca[hh], b = cb[hh], c = cc[hh];
#pragma unroll
            for (int e = 0; e < 4; ++e) { s[8 * hh + 2 * e] = bf2f(a[e] & 0xffffu) + bf2f(b[e] & 0xffffu); s[8 * hh + 2 * e + 1] = bf2f(a[e] >> 16) + bf2f(b[e] >> 16);
                zz[8 * hh + 2 * e] = bf2f(c[e] & 0xffffu); zz[8 * hh + 2 * e + 1] = bf2f(c[e] >> 16); }
        }
        float ss = 0.f;
#pragma unroll
        for (int e = 0; e < 16; ++e) ss += s[e] * s[e];
        ss += __int_as_float(__builtin_amdgcn_update_dpp(0, __float_as_int(ss), 0xB1, 0xf, 0xf, false));
        ss += __int_as_float(__builtin_amdgcn_update_dpp(0, __float_as_int(ss), 0x4E, 0xf, 0xf, false));
        ss += __int_as_float(__builtin_amdgcn_update_dpp(0, __float_as_int(ss), 0x141, 0xf, 0xf, false));
        const float rstd = rsqrtf(ss * (1.f / 128.f) + EPSF);
        u32x4 o[2];
#pragma unroll
        for (int hh = 0; hh < 2; ++hh)
#pragma unroll
            for (int e = 0; e < 4; ++e) { const int i0 = 8 * hh + 2 * e; const float v0 = s[i0] * rstd * gv[i0] * zz[i0], v1 = s[i0 + 1] * rstd * gv[i0 + 1] * zz[i0 + 1]; o[hh][e] = pk2(v0, v1); }
        *(u32x4*)(out + (size_t)m * DM + 16 * lane) = o[0]; *(u32x4*)(out + (size_t)m * DM + 16 * lane + 8) = o[1];
#pragma unroll
        for (int hh = 0; hh < 2; ++hh) { ca[hh] = na[hh]; cb[hh] = nb[hh]; cc[hh] = nc[hh]; }
    }
#undef GT_LOADROW
}

__device__ __forceinline__ int scan_item_of(int rnd, int bid, int G) {
    if (G == 256) { if (rnd == 0) return bid; if (rnd == 1 && bid >= 128) return bid + 128; return -1; }
    const int it = bid + rnd * G; return it < 384 ? it : -1;
}

constexpr int G_QS = 0, G_KS = 17408, G_KBG = 34816, G_KTL = 53248, G_VB = 71680, G_NW = 90112, G_QK = 107520, G_CW = 116736, G_LB = 124416, G_LD = 133632, G_TB = 137984, G_OS = G_LB, G_GW = 141824, G_BW = 143872, G_EW = 145920;
__device__ __forceinline__ void conv_phase(LAS unsigned char* lds, CPP P, int bid, int G) {
    int tid_ = threadIdx.x; asm volatile("" : "+v"(tid_)); const int tid = tid_;
    bf16_t* proj = (bf16_t*)(P->ws + WS_BIG);
    LAS float* CW = (LAS float*)(lds + G_CW);
    const int c8 = tid & 15, r = tid >> 4, tlo = 2 * r;
    int hcw = bid & 7;
#define CU_LOADCW(hh) do { for (int i = tid; i < 3 * 5 * 128; i += NTHREADS) { const int sec = i / 640, tap = (i / 128) % 5, cc = i & 127; CW[i] = P->in[10][tap * 3072 + sec * 1024 + (hh) * 128 + cc]; } } while (0)
    CU_LOADCW(hcw);
    u32x4 rq[6], rk[6], rv[6], nq[6], nk[6], nv[6];
#define CU_PBASE(unit) (proj + (size_t)(NPR + ((unit) >> 8) * TS + (((unit) >> 3) & 31) * 64 + tlo) * LD0 + ((unit) & 7) * 128 + c8 * 8)
#define CU_LOAD(unit, q_, k_, v_) do { const bf16_t* pb_ = CU_PBASE(unit); _Pragma("unroll") for (int i = 0; i < 6; ++i) { const int tt = tlo - 2 + i; const bool ok = (tt >= 0 && tt < 64); const bf16_t* pr = pb_ + (ptrdiff_t)(ok ? (i - 2) : 0) * LD0; \
        const u32x4 a = *(const u32x4*)(pr), bb = *(const u32x4*)(pr + 1024), c = *(const u32x4*)(pr + 2048); const u32x4 z = (u32x4){0u, 0u, 0u, 0u}; q_[i] = ok ? a : z; k_[i] = ok ? bb : z; v_[i] = ok ? c : z; } } while (0)
    if (bid < 2048) CU_LOAD(bid, rq, rk, rv);
    for (int unit = bid; unit < 2048; unit += G) {
        const bool has_next = (unit + G < 2048);
        if ((unit & 7) != hcw) { __syncthreads(); hcw = unit & 7; CU_LOADCW(hcw); }
        if (has_next) { CU_LOAD(unit + G, nq, nk, nv); asm volatile("s_waitcnt vmcnt(18) lgkmcnt(0)" ::: "memory"); }
        else asm volatile("s_waitcnt vmcnt(0) lgkmcnt(0)" ::: "memory");
        __builtin_amdgcn_s_barrier(); asm volatile("" ::: "memory");
        bf16_t* pbase = CU_PBASE(unit);
#define CU_CONV(sec, rw, al, ah) do { f32x2 al2[4], ah2[4]; _Pragma("unroll") for (int e = 0; e < 4; ++e) { al2[e] = (f32x2){0.f, 0.f}; ah2[e] = (f32x2){0.f, 0.f}; } \
        _Pragma("unroll") for (int i = 0; i < 6; ++i) { f32x2 x2[4]; \
            _Pragma("unroll") for (int e = 0; e < 4; ++e) { x2[e][0] = __uint_as_float(rw[i][e] << 16); x2[e][1] = __uint_as_float(rw[i][e] & 0xffff0000u); } \
            if (i < 5) { const LAS float* cw = CW + ((sec) * 5 + i) * 128 + c8 * 8; const f32x4 w0 = *(const LAS f32x4*)cw, w1 = *(const LAS f32x4*)(cw + 4); \
                al2[0] += x2[0] * (f32x2){w0[0], w0[1]}; al2[1] += x2[1] * (f32x2){w0[2], w0[3]}; al2[2] += x2[2] * (f32x2){w1[0], w1[1]}; al2[3] += x2[3] * (f32x2){w1[2], w1[3]}; } \
            if (i > 0) { const LAS float* cw = CW + ((sec) * 5 + i - 1) * 128 + c8 * 8; const f32x4 w0 = *(const LAS f32x4*)cw, w1 = *(const LAS f32x4*)(cw + 4); \
                ah2[0] += x2[0] * (f32x2){w0[0], w0[1]}; ah2[1] += x2[1] * (f32x2){w0[2], w0[3]}; ah2[2] += x2[2] * (f32x2){w1[0], w1[1]}; ah2[3] += x2[3] * (f32x2){w1[2], w1[3]}; } } \
        _Pragma("unroll") for (int e = 0; e < 4; ++e) { al[2 * e] = silu_f(al2[e][0]); al[2 * e + 1] = silu_f(al2[e][1]); ah[2 * e] = silu_f(ah2[e][0]); ah[2 * e + 1] = silu_f(ah2[e][1]); } } while (0)
#define CU_STORE(sec, al, ah, rl, rh) do { u32x4 lo4, hi4; _Pragma("unroll") for (int e = 0; e < 4; ++e) { lo4[e] = pk2(al[2 * e] * (rl), al[2 * e + 1] * (rl)); hi4[e] = pk2(ah[2 * e] * (rh), ah[2 * e + 1] * (rh)); } \
        *(u32x4*)(pbase + (sec) * 1024) = lo4; *(u32x4*)(pbase + LD0 + (sec) * 1024) = hi4; } while (0)
    float al[8], ah[8];
#pragma unroll
    for (int sec = 0; sec < 3; ++sec) {
        if (sec == 0) CU_CONV(0, rq, al, ah); else if (sec == 1) CU_CONV(1, rk, al, ah); else CU_CONV(2, rv, al, ah);
        float rl = 1.f, rh = 1.f;
        if (sec < 2) { float sl = 0.f, sh = 0.f;
#pragma unroll
            for (int e = 0; e < 8; ++e) { sl += al[e] * al[e]; sh += ah[e] * ah[e]; }
#pragma unroll
            for (int o = 1; o < 16; o <<= 1) { sl += __shfl_xor(sl, o); sh += __shfl_xor(sh, o); }
            const float scl = (sec == 0) ? 0.08838834764831845f : 1.f; rl = rsqrtf(sl + EPSF) * scl; rh = rsqrtf(sh + EPSF) * scl; }
        CU_STORE(sec, al, ah, rl, rh);
    }
#pragma unroll
        for (int i = 0; i < 6; ++i) { rq[i] = nq[i]; rk[i] = nk[i]; rv[i] = nv[i]; }
    }
#undef CU_CONV
#undef CU_STORE
#undef CU_LOAD
#undef CU_PBASE
#undef CU_LOADCW
    __syncthreads();
}

__device__ __forceinline__ void gdn_item(LAS unsigned char* lds, CPP P, int item) {
    int tid_ = threadIdx.x; asm volatile("" : "+v"(tid_)); const int tid0 = tid_, lane0 = tid0 & 63, wid = __builtin_amdgcn_readfirstlane(tid0 >> 6), fr0 = lane0 & 15, fq0 = lane0 >> 4;
    const bool samp = item < 128; const int p = samp ? item : item - 128;
    const int b = p >> 4, h = (p >> 1) & 7, d = p & 1;
    const int T = samp ? TS : TP, m0 = samp ? NPR + b * TS : b * TP, NC = T / 64;
    const bf16_t* proj = (const bf16_t*)(P->ws + WS_BIG);
    bf16_t* od = (bf16_t*)(P->ws + (d ? WS_210 : WS_170));
    LAS bf16_t* QS = (LAS bf16_t*)(lds + G_QS); LAS bf16_t* KS = (LAS bf16_t*)(lds + G_KS); LAS bf16_t* KBG = (LAS bf16_t*)(lds + G_KBG); LAS bf16_t* KTL = (LAS bf16_t*)(lds + G_KTL);
    LAS bf16_t* VB = (LAS bf16_t*)(lds + G_VB); LAS bf16_t* NW = (LAS bf16_t*)(lds + G_NW); LAS bf16_t* QK = (LAS bf16_t*)(lds + G_QK); LAS bf16_t* LB = (LAS bf16_t*)(lds + G_LB);
    LAS float* LD = (LAS float*)(lds + G_LD); LAS bf16_t* TB = (LAS bf16_t*)(lds + G_TB); LAS float* CW = (LAS float*)(lds + G_CW); LAS bf16_t* OS = (LAS bf16_t*)(lds + G_OS);
    for (int i = tid0; i < 3 * 5 * 128; i += NTHREADS) { const int sec = i / 640, tap = (i / 128) % 5, cc = i & 127; CW[i] = P->in[10][tap * 3072 + sec * 1024 + h * 128 + cc]; }
    const float A_neg = -__expf(P->in[11][d * 8 + h]), dtb = P->in[12][d * 8 + h];
    f32x4 S[8];
    if (samp) { const float* s0 = P->in[2] + ((size_t)(b * 2 + d) * 8 + h) * 16384;
#pragma unroll
        for (int kb = 0; kb < 8; ++kb)
#pragma unroll
            for (int j = 0; j < 4; ++j) S[kb][j] = s0[(16 * kb + 4 * fq0 + j) * 128 + 16 * wid + fr0]; }
    else {
#pragma unroll
        for (int kb = 0; kb < 8; ++kb) S[kb] = (f32x4){0.f, 0.f, 0.f, 0.f}; }
    LAS float* GW = (LAS float*)(lds + G_GW) + wid * 64; LAS float* BW = (LAS float*)(lds + G_BW) + wid * 64; LAS float* EW = (LAS float*)(lds + G_EW) + wid * 64;
    u32x4 rq[6], rk[6], rv[6]; unsigned gbr, gar;
#define TOKN(nn, i) (d ? (T - 1 - (64 * (nn) + (i))) : (64 * (nn) + (i)))
#define GDN_ISSUE(nn, tidx) do { const int c8_ = (tidx) & 15, r_ = (tidx) >> 4; const int tA_ = TOKN(nn, 2 * r_), tB_ = TOKN(nn, 2 * r_ + 1); const int tlo_ = tA_ < tB_ ? tA_ : tB_; \
        const bf16_t* pb_ = proj + (size_t)(m0 + tlo_) * LD0 + h * 128 + c8_ * 8; \
        if (samp) { rq[2] = *(const u32x4*)(pb_); rk[2] = *(const u32x4*)(pb_ + 1024); rv[2] = *(const u32x4*)(pb_ + 2048); rq[3] = *(const u32x4*)(pb_ + LD0); rk[3] = *(const u32x4*)(pb_ + LD0 + 1024); rv[3] = *(const u32x4*)(pb_ + LD0 + 2048); } \
        else { _Pragma("unroll") for (int i = 0; i < 6; ++i) { const int tt = tlo_ - 2 + i; const bool ok = (tt >= 0 && tt < T); const bf16_t* pr_ = pb_ + (ptrdiff_t)(ok ? (i - 2) : 0) * LD0; \
            const u32x4 a_ = *(const u32x4*)(pr_), b_ = *(const u32x4*)(pr_ + 1024), c_ = *(const u32x4*)(pr_ + 2048); const u32x4 z_ = (u32x4){0u, 0u, 0u, 0u}; rq[i] = ok ? a_ : z_; rk[i] = ok ? b_ : z_; rv[i] = ok ? c_ : z_; } } \
        const bf16_t* pg_ = proj + (size_t)(m0 + TOKN(nn, (tidx) & 63)) * LD0 + 4096 + d * 8 + h; gbr = pg_[0]; gar = pg_[16]; } while (0)
    GDN_ISSUE(0, tid0);
    LDS_SYNC();
    for (int n = 0; n < NC; ++n) {
        int tid = tid0; asm volatile("" : "+v"(tid));
        const int lane = tid & 63, fr = lane & 15, fq = lane >> 4;
        float Glast;
        { const float braw = bf2f(gbr), araw = bf2f(gar);
          const float beta_l = sigmoid_f(braw); const float xx = araw + dtb; const float sp = (xx > 20.f) ? xx : __logf(1.f + __expf(xx)); float g = A_neg * sp;
          { int x_;
#define DPPADD(ctrl, rmask) do { x_ = __builtin_amdgcn_update_dpp(0, __float_as_int(g), (ctrl), (rmask), 0xf, false); g += __int_as_float(x_); } while (0)
            DPPADD(0x111, 0xf); DPPADD(0x112, 0xf); DPPADD(0x114, 0xf); DPPADD(0x118, 0xf); DPPADD(0x142, 0xa); DPPADD(0x143, 0xc);
#undef DPPADD
          }
          GW[lane] = g; BW[lane] = beta_l; EW[lane] = __expf(g); Glast = __int_as_float(__builtin_amdgcn_readlane(__float_as_int(g), 63)); }
_Pragma("unroll")
        for (int rep_ = 0; rep_ < (PROBE_GCONV2 ? 2 : 1); ++rep_)
        { const int c8 = tid & 15, r = tid >> 4;
          const int rlo = d ? 2 * r + 1 : 2 * r, rhi = d ? 2 * r : 2 * r + 1;
          const float be_lo = BW[rlo], be_hi = BW[rhi], G_lo = GW[rlo], G_hi = GW[rhi];
          const int tlo_off = 4 * ((rlo >> 2) ^ c8) + (rlo & 3), thi_off = 4 * ((rhi >> 2) ^ c8) + (rhi & 3);
#define GDN_CONV(sec, rw, al, ah) do { f32x2 al2[4], ah2[4]; _Pragma("unroll") for (int e = 0; e < 4; ++e) { al2[e] = (f32x2){0.f, 0.f}; ah2[e] = (f32x2){0.f, 0.f}; } \
              _Pragma("unroll") for (int i = 0; i < 6; ++i) { f32x2 x2[4]; \
                  _Pragma("unroll") for (int e = 0; e < 4; ++e) { x2[e][0] = __uint_as_float(rw[i][e] << 16); x2[e][1] = __uint_as_float(rw[i][e] & 0xffff0000u); } \
                  if (i < 5) { const LAS float* cw = CW + ((sec) * 5 + i) * 128 + c8 * 8; const f32x4 w0 = *(const LAS f32x4*)cw, w1 = *(const LAS f32x4*)(cw + 4); \
                      al2[0] += x2[0] * (f32x2){w0[0], w0[1]}; al2[1] += x2[1] * (f32x2){w0[2], w0[3]}; al2[2] += x2[2] * (f32x2){w1[0], w1[1]}; al2[3] += x2[3] * (f32x2){w1[2], w1[3]}; } \
                  if (i > 0) { const LAS float* cw = CW + ((sec) * 5 + i - 1) * 128 + c8 * 8; const f32x4 w0 = *(const LAS f32x4*)cw, w1 = *(const LAS f32x4*)(cw + 4); \
                      ah2[0] += x2[0] * (f32x2){w0[0], w0[1]}; ah2[1] += x2[1] * (f32x2){w0[2], w0[3]}; ah2[2] += x2[2] * (f32x2){w1[0], w1[1]}; ah2[3] += x2[3] * (f32x2){w1[2], w1[3]}; } } \
              _Pragma("unroll") for (int e = 0; e < 4; ++e) { al[2 * e] = silu_f(al2[e][0]); al[2 * e + 1] = silu_f(al2[e][1]); ah[2 * e] = silu_f(ah2[e][0]); ah[2 * e + 1] = silu_f(ah2[e][1]); } } while (0)
#define GDN_NORM(al, ah, scl, rl, rh) do { float sl = 0.f, sh = 0.f; \
              _Pragma("unroll") for (int e = 0; e < 8; ++e) { sl += al[e] * al[e]; sh += ah[e] * ah[e]; } \
              _Pragma("unroll") for (int o = 1; o < 16; o <<= 1) { sl += __shfl_xor(sl, o); sh += __shfl_xor(sh, o); } \
              rl = rsqrtf(sl + EPSF) * (scl); rh = rsqrtf(sh + EPSF) * (scl); } while (0)
          float al[8], ah[8]; float rl, rh;
          if (samp) {
              *(LAS u32x4*)(QS + rlo * 136 + c8 * 8) = rq[2]; *(LAS u32x4*)(QS + rhi * 136 + c8 * 8) = rq[3];
              *(LAS u32x4*)(KS + rlo * 136 + c8 * 8) = rk[2]; *(LAS u32x4*)(KS + rhi * 136 + c8 * 8) = rk[3];
#pragma unroll
              for (int e = 0; e < 4; ++e) { al[2 * e] = __uint_as_float(rk[2][e] << 16); al[2 * e + 1] = __uint_as_float(rk[2][e] & 0xffff0000u); ah[2 * e] = __uint_as_float(rk[3][e] << 16); ah[2 * e + 1] = __uint_as_float(rk[3][e] & 0xffff0000u); }
              { const float bgl = be_lo * __expf(G_lo), bgh = be_hi * __expf(G_hi), tll = __expf(Glast - G_lo), tlh = __expf(Glast - G_hi);
#pragma unroll
                for (int e = 0; e < 8; ++e) { const int cb = (c8 * 8 + e) * 72;
                    KBG[cb + tlo_off] = (bf16_t)(pk2(al[e] * bgl, 0.f) & 0xffffu); KBG[cb + thi_off] = (bf16_t)(pk2(ah[e] * bgh, 0.f) & 0xffffu);
                    KTL[cb + tlo_off] = (bf16_t)(pk2(al[e] * tll, 0.f) & 0xffffu); KTL[cb + thi_off] = (bf16_t)(pk2(ah[e] * tlh, 0.f) & 0xffffu); } }
#pragma unroll
              for (int e = 0; e < 4; ++e) { al[2 * e] = __uint_as_float(rv[2][e] << 16); al[2 * e + 1] = __uint_as_float(rv[2][e] & 0xffff0000u); ah[2 * e] = __uint_as_float(rv[3][e] << 16); ah[2 * e + 1] = __uint_as_float(rv[3][e] & 0xffff0000u); }
#pragma unroll
              for (int e = 0; e < 8; ++e) { const int cb = (c8 * 8 + e) * 72; VB[cb + tlo_off] = (bf16_t)(pk2(al[e] * be_lo, 0.f) & 0xffffu); VB[cb + thi_off] = (bf16_t)(pk2(ah[e] * be_hi, 0.f) & 0xffffu); }
          } else {
          GDN_CONV(0, rq, al, ah);
          GDN_NORM(al, ah, 0.08838834764831845f, rl, rh);
          { u32x4 lo4, hi4;
#pragma unroll
            for (int e = 0; e < 4; ++e) { lo4[e] = pk2(al[2 * e] * rl, al[2 * e + 1] * rl); hi4[e] = pk2(ah[2 * e] * rh, ah[2 * e + 1] * rh); }
            *(LAS u32x4*)(QS + rlo * 136 + c8 * 8) = lo4; *(LAS u32x4*)(QS + rhi * 136 + c8 * 8) = hi4; }
          GDN_CONV(1, rk, al, ah);
          GDN_NORM(al, ah, 1.f, rl, rh);
          { u32x4 lo4, hi4;
#pragma unroll
            for (int e = 0; e < 4; ++e) { lo4[e] = pk2(al[2 * e] * rl, al[2 * e + 1] * rl); hi4[e] = pk2(ah[2 * e] * rh, ah[2 * e + 1] * rh); }
            *(LAS u32x4*)(KS + rlo * 136 + c8 * 8) = lo4; *(LAS u32x4*)(KS + rhi * 136 + c8 * 8) = hi4;
            const float bgl = rl * be_lo * __expf(G_lo), bgh = rh * be_hi * __expf(G_hi), tll = rl * __expf(Glast - G_lo), tlh = rh * __expf(Glast - G_hi);
#pragma unroll
            for (int e = 0; e < 8; ++e) { const int cb = (c8 * 8 + e) * 72;
                KBG[cb + tlo_off] = (bf16_t)(pk2(al[e] * bgl, 0.f) & 0xffffu); KBG[cb + thi_off] = (bf16_t)(pk2(ah[e] * bgh, 0.f) & 0xffffu);
                KTL[cb + tlo_off] = (bf16_t)(pk2(al[e] * tll, 0.f) & 0xffffu); KTL[cb + thi_off] = (bf16_t)(pk2(ah[e] * tlh, 0.f) & 0xffffu); } }
          GDN_CONV(2, rv, al, ah);
#pragma unroll
          for (int e = 0; e < 8; ++e) { const int cb = (c8 * 8 + e) * 72; VB[cb + tlo_off] = (bf16_t)(pk2(al[e] * be_lo, 0.f) & 0xffffu); VB[cb + thi_off] = (bf16_t)(pk2(ah[e] * be_hi, 0.f) & 0xffffu); }
          }
#undef GDN_CONV
#undef GDN_NORM
        }
        LDS_SYNC();
        f32x4 U[4];
        for (int rep2_ = 0; rep2_ < (PROBE_GSOLVE2 ? 2 : 1); ++rep2_) {
        { const int ntile = (wid < 4) ? 2 : 3;
          for (int tq = 0; tq < ntile; ++tq) {
            int ty, ci, si;
            if (wid < 4 && tq == 0) { ty = 0; ci = wid; si = wid; }
            else { const int k = (wid < 4) ? wid : 4 + 3 * (wid - 4) + tq;
                   if (k < 6) { ty = 0; ci = (k < 1) ? 1 : (k < 3) ? 2 : 3; si = k - (ci * (ci - 1)) / 2; }
                   else { ty = 1; const int idx = k - 6; ci = (idx >= 6) ? 3 : (idx >= 3) ? 2 : (idx >= 1) ? 1 : 0; si = idx - (ci * (ci + 1)) / 2; } }
            const LAS bf16_t* Bsrc = ty ? QS : KS; f32x4 acc = (f32x4){0.f, 0.f, 0.f, 0.f};
#pragma unroll
            for (int ks = 0; ks < 4; ++ks) { const bf16x8 a = *(const LAS bf16x8*)(KS + (16 * si + fr) * 136 + 32 * ks + 8 * fq); const bf16x8 bb = *(const LAS bf16x8*)(Bsrc + (16 * ci + fr) * 136 + 32 * ks + 8 * fq); acc = mfma32(a, bb, acc); }
            const int c = 16 * ci + fr; const float Gc = GW[c], bc = BW[c]; const f32x4 Gs4 = *(const LAS f32x4*)(GW + 16 * si + 4 * fq);
            float val[4];
#pragma unroll
            for (int j = 0; j < 4; ++j) { const int s = 16 * si + 4 * fq + j; const float Gs = Gs4[j];
                if (ty == 0) val[j] = (s < c) ? bc * acc[j] * __expf(Gc - Gs) : 0.f; else val[j] = (s <= c) ? acc[j] * __expf(Gc - Gs) : 0.f; }
            if (ty == 0) { u32x2 o; o.x = pk2(-val[0], -val[1]); o.y = pk2(-val[2], -val[3]); *(LAS u32x2*)(LB + c * 72 + 16 * si + 4 * fq) = o; }
            else { u32x2 o; o.x = pk2(val[0], val[1]); o.y = pk2(val[2], val[3]); *(LAS u32x2*)(QK + c * 72 + 16 * si + 4 * fq) = o; }
            if (wid < 4 && tq == 0) {
#pragma unroll
                for (int j = 0; j < 4; ++j) LD[(wid * 16 + fr) * 17 + 4 * fq + j] = val[j];
                if (lane < 16) { const LAS float* Lp = LD + wid * 16 * 17; float Tc[16];
#pragma unroll
                    for (int r = 0; r < 16; ++r) { float a = (r == lane) ? 1.f : 0.f;
#pragma unroll
                        for (int s = 0; s < r; ++s) a -= Lp[r * 17 + s] * Tc[s];
                        Tc[r] = a; }
#pragma unroll
                    for (int r = 0; r < 16; ++r) TB[(wid * 16 + r) * 20 + lane] = (bf16_t)(pk2(Tc[r], 0.f) & 0xffffu); }
            }
          } }
        LDS_SYNC();
        { s16x4 Td[4];
#pragma unroll
          for (int i = 0; i < 4; ++i) Td[i] = *(const LAS s16x4*)(TB + (i * 16 + fr) * 20 + 4 * fq);
          s16x4 Ln[6];
          Ln[0] = *(const LAS s16x4*)(LB + (16 + fr) * 72 + 4 * fq); Ln[1] = *(const LAS s16x4*)(LB + (32 + fr) * 72 + 4 * fq); Ln[2] = *(const LAS s16x4*)(LB + (32 + fr) * 72 + 16 + 4 * fq);
          Ln[3] = *(const LAS s16x4*)(LB + (48 + fr) * 72 + 4 * fq); Ln[4] = *(const LAS s16x4*)(LB + (48 + fr) * 72 + 16 + 4 * fq); Ln[5] = *(const LAS s16x4*)(LB + (48 + fr) * 72 + 32 + 4 * fq);
          const f32x4 zero = (f32x4){0.f, 0.f, 0.f, 0.f};
          const int swz = 2 * wid + (fr >> 3);
#pragma unroll
          for (int part = 0; part < 2; ++part) { const LAS bf16_t* RB = (part ? KBG : VB) + (16 * wid + fr) * 72;
              const s16x4 B0 = *(const LAS s16x4*)(RB + 4 * ((0 + fq) ^ swz)), B1 = *(const LAS s16x4*)(RB + 4 * ((4 + fq) ^ swz)), B2 = *(const LAS s16x4*)(RB + 4 * ((8 + fq) ^ swz)), B3 = *(const LAS s16x4*)(RB + 4 * ((12 + fq) ^ swz));
              f32x4 X0 = mfma16(Td[0], B0, zero); const s16x4 x0 = pk4(X0);
              f32x4 Y = mfma16(Ln[0], x0, unpk4(B1)); f32x4 X1 = mfma16(Td[1], pk4(Y), zero); const s16x4 x1 = pk4(X1);
              Y = mfma16(Ln[1], x0, unpk4(B2)); Y = mfma16(Ln[2], x1, Y); f32x4 X2 = mfma16(Td[2], pk4(Y), zero); const s16x4 x2 = pk4(X2);
              Y = mfma16(Ln[3], x0, unpk4(B3)); Y = mfma16(Ln[4], x1, Y); Y = mfma16(Ln[5], x2, Y); f32x4 X3 = mfma16(Td[3], pk4(Y), zero);
              if (part == 0) { U[0] = X0; U[1] = X1; U[2] = X2; U[3] = X3; }
              else {
#pragma unroll
                  for (int j = 0; j < 4; ++j) { NW[(4 * fq + j) * 136 + 16 * wid + fr] = (bf16_t)(pk2(-X0[j], 0.f) & 0xffffu); NW[(16 + 4 * fq + j) * 136 + 16 * wid + fr] = (bf16_t)(pk2(-X1[j], 0.f) & 0xffffu);
                      NW[(32 + 4 * fq + j) * 136 + 16 * wid + fr] = (bf16_t)(pk2(-X2[j], 0.f) & 0xffffu); NW[(48 + 4 * fq + j) * 136 + 16 * wid + fr] = (bf16_t)(pk2(-X3[j], 0.f) & 0xffffu); } }
          } }
        LDS_SYNC();
        }
        if (n + 1 < NC) GDN_ISSUE(n + 1, tid);
        { s16x4 Sb[8];
#pragma unroll
          for (int kb = 0; kb < 8; ++kb) Sb[kb] = pk4(S[kb]);
          f32x4 oa[4];
#pragma unroll
          for (int i = 0; i < 4; ++i) { oa[i] = (f32x4){0.f, 0.f, 0.f, 0.f};
#pragma unroll
              for (int kb = 0; kb < 8; ++kb) { const s16x4 a = *(const LAS s16x4*)(NW + (16 * i + fr) * 136 + 16 * kb + 4 * fq); U[i] = mfma16(a, Sb[kb], U[i]);
                  const s16x4 a2 = *(const LAS s16x4*)(QS + (16 * i + fr) * 136 + 16 * kb + 4 * fq); oa[i] = mfma16(a2, Sb[kb], oa[i]); } }
#pragma unroll
          for (int i = 0; i < 4; ++i) oa[i] = oa[i] * *(const LAS f32x4*)(EW + 16 * i + 4 * fq);
          s16x4 vb[4];
#pragma unroll
          for (int i = 0; i < 4; ++i) vb[i] = pk4(U[i]);
#pragma unroll
          for (int i = 0; i < 4; ++i)
#pragma unroll
              for (int si = 0; si <= i; ++si) { const s16x4 a = *(const LAS s16x4*)(QK + (16 * i + fr) * 72 + 16 * si + 4 * fq); oa[i] = mfma16(a, vb[si], oa[i]); }
          const float gl = __expf(Glast);
#pragma unroll
          for (int kb = 0; kb < 8; ++kb) { S[kb] = S[kb] * gl; const int swk = 2 * kb + (fr >> 3);
#pragma unroll
              for (int i = 0; i < 4; ++i) { const s16x4 a = *(const LAS s16x4*)(KTL + (16 * kb + fr) * 72 + 4 * ((4 * i + fq) ^ swk)); S[kb] = mfma16(a, vb[i], S[kb]); } }
#pragma unroll
          for (int i = 0; i < 4; ++i)
#pragma unroll
              for (int j = 0; j < 4; ++j) OS[(16 * i + 4 * fq + j) * 136 + 16 * wid + fr] = (bf16_t)(pk2(oa[i][j], 0.f) & 0xffffu);
        }
        LDS_SYNC();
        { const int row = tid >> 3, seg = tid & 7; const int t = TOKN(n, row);
          const u32x4 v0 = *(const LAS u32x4*)(OS + row * 136 + seg * 16), v1 = *(const LAS u32x4*)(OS + row * 136 + seg * 16 + 8);
          bf16_t* dst = od + (size_t)(m0 + t) * DM + h * 128 + seg * 16; *(u32x4*)dst = v0; *(u32x4*)(dst + 8) = v1; }
    }
#undef GDN_ISSUE
#undef TOKN
    LDS_SYNC();
    if (!samp) { float* so = P->out + OUT_SG + ((size_t)(b * 2 + d) * 8 + h) * 16384;
#pragma unroll
        for (int kb = 0; kb < 8; ++kb)
#pragma unroll
            for (int j = 0; j < 4; ++j) so[(16 * kb + 4 * fq0 + j) * 128 + 16 * wid + fr0] = S[kb][j]; }
}

constexpr int H_QI = 0, H_KO = 17408, H_KT = 34816, H_VT = 53248, H_FL = 71680;
template <bool DUMMY>
__device__ __forceinline__ void hgrn_item(LAS unsigned char* lds, CPP P, int item) {
    int tid_ = threadIdx.x; asm volatile("" : "+v"(tid_)); const int tid = tid_, lane = tid & 63, wid = __builtin_amdgcn_readfirstlane(tid >> 6), fr = lane & 15, fq = lane >> 4;
    const bool samp = item < 128; const int p = samp ? item : item - 128;
    const int b = p >> 4, h = (p >> 1) & 7, d = p & 1;
    const int T = samp ? TS : TP, m0 = samp ? NPR + b * TS : b * TP, NC = T / 64;
    bf16_t* proj = (bf16_t*)(P->ws + WS_BIG);
    LAS bf16_t* QI = (LAS bf16_t*)(lds + H_QI); LAS bf16_t* KO = (LAS bf16_t*)(lds + H_KO); LAS bf16_t* KT = (LAS bf16_t*)(lds + H_KT); LAS bf16_t* VT = (LAS bf16_t*)(lds + H_VT); LAS float* FL = (LAS float*)(lds + H_FL);
    const int c = tid & 127, cc = tid >> 7;
    f32x4 S[8];
    if (samp) { const float* s0 = P->in[3] + ((size_t)(b * 2 + d) * 8 + h) * 16384;
#pragma unroll
        for (int kb = 0; kb < 8; ++kb)
#pragma unroll
            for (int j = 0; j < 4; ++j) S[kb][j] = s0[(16 * kb + 4 * fq + j) * 128 + 16 * wid + fr]; }
    else {
#pragma unroll
        for (int kb = 0; kb < 8; ++kb) S[kb] = (f32x4){0.f, 0.f, 0.f, 0.f}; }
    const size_t colq = (size_t)h * 128, colf = (size_t)1024 + d * 1024 + h * 128, colv = (size_t)3072 + h * 128;
    unsigned pq[16], pf[16], pv[16];
    const int tsgn = d ? -1 : 1;
#define H_T0(nn) (d ? (T - 1 - 64 * (nn)) : 64 * (nn))
#define H_ISSUE(nn) do { const bf16_t* pr0_ = proj + (size_t)(m0 + H_T0(nn)) * LD1 + (ptrdiff_t)(tsgn * 16 * cc) * LD1 + c; const ptrdiff_t st_ = (ptrdiff_t)tsgn * LD1; \
        _Pragma("unroll") for (int ta = 0; ta < 16; ++ta) { const bf16_t* pr_ = pr0_ + ta * st_; pq[ta] = pr_[colq]; pf[ta] = pr_[colf]; pv[ta] = pr_[colv]; } } while (0)
    H_ISSUE(0);
    for (int n = 0; n < NC; ++n) {
        auto tok = [&](int i) -> int { return d ? (T - 1 - (64 * n + i)) : (64 * n + i); };
        { float ko[16]; float ebc = 1.f;
#pragma unroll
          for (int ta = 0; ta < 16; ++ta) { const int i = 16 * cc + ta;
              const float qs = bf2f(pq[ta]), f = bf2f(pf[ta]);
              ebc *= f; ko[ta] = (1.f - f) * __builtin_amdgcn_rcpf(ebc);
              QI[i * 136 + c] = (bf16_t)(pk2(qs * ebc, 0.f) & 0xffffu); KO[i * 136 + c] = (bf16_t)(pk2(ko[ta], 0.f) & 0xffffu); }
          u32x4 k0, k1, v0, v1;
#pragma unroll
          for (int e = 0; e < 4; ++e) { k0[e] = pk2(ko[2 * e] * ebc, ko[2 * e + 1] * ebc); k1[e] = pk2(ko[8 + 2 * e] * ebc, ko[9 + 2 * e] * ebc);
              v0[e] = pv[2 * e] | (pv[2 * e + 1] << 16); v1[e] = pv[8 + 2 * e] | (pv[9 + 2 * e] << 16); }
          *(LAS u32x4*)(KT + c * 72 + 16 * cc) = k0; *(LAS u32x4*)(KT + c * 72 + 16 * cc + 8) = k1; *(LAS u32x4*)(VT + c * 72 + 16 * cc) = v0; *(LAS u32x4*)(VT + c * 72 + 16 * cc + 8) = v1;
          FL[cc * 128 + c] = ebc; }
        LDS_SYNC();
        if (n + 1 < NC) H_ISSUE(n + 1);
#pragma unroll 1
        for (int q4 = 0; q4 < 4; ++q4) {
            f32x4 at = (f32x4){0.f, 0.f, 0.f, 0.f};
#pragma unroll
            for (int ks = 0; ks < 4; ++ks) { const bf16x8 a = *(const LAS bf16x8*)(KO + (16 * q4 + fr) * 136 + 32 * ks + 8 * fq); const bf16x8 bb = *(const LAS bf16x8*)(QI + (16 * q4 + fr) * 136 + 32 * ks + 8 * fq); at = mfma32(a, bb, at); }
#pragma unroll
            for (int j = 0; j < 4; ++j) at[j] = (4 * fq + j <= fr) ? at[j] : 0.f;
            const s16x4 atb = pk4(at);
            f32x4 oa = (f32x4){0.f, 0.f, 0.f, 0.f};
#pragma unroll
            for (int kp = 0; kp < 4; ++kp) { const LAS bf16_t* pa = QI + (16 * q4 + fr) * 136 + 32 * kp + 4 * fq;
                oa = mfma32(__builtin_shufflevector(*(const LAS s16x4*)pa, *(const LAS s16x4*)(pa + 16), 0, 1, 2, 3, 4, 5, 6, 7), __builtin_shufflevector(pk4(S[2 * kp]), pk4(S[2 * kp + 1]), 0, 1, 2, 3, 4, 5, 6, 7), oa); }
            const s16x4 bv = *(const LAS s16x4*)(VT + (16 * wid + fr) * 72 + 16 * q4 + 4 * fq);
            oa = mfma16(atb, bv, oa);
#pragma unroll
            for (int kb = 0; kb < 8; ++kb) { const f32x4 fl = *(const LAS f32x4*)(FL + q4 * 128 + 16 * kb + 4 * fq); S[kb] = S[kb] * fl;
                const s16x4 a = *(const LAS s16x4*)(KT + (16 * kb + fr) * 72 + 16 * q4 + 4 * fq); S[kb] = mfma16(a, bv, S[kb]); }
            { bf16_t* op0 = DUMMY ? (bf16_t*)(P->ws + WS_200) + (size_t)(m0 + H_T0(n) + tsgn * (16 * q4 + 4 * fq)) * DM + h * 128 + 16 * wid + fr : proj + (size_t)(m0 + H_T0(n) + tsgn * (16 * q4 + 4 * fq)) * LD1 + colf + 16 * wid + fr; const ptrdiff_t ost = (ptrdiff_t)tsgn * (DUMMY ? DM : LD1);
#pragma unroll
            for (int j = 0; j < 4; ++j) op0[j * ost] = (bf16_t)(pk2(oa[j], 0.f) & 0xffffu); }
        }
        LDS_SYNC();
    }
    if (!samp) { float* so = P->out + OUT_SH + ((size_t)(b * 2 + d) * 8 + h) * 16384;
#pragma unroll
        for (int kb = 0; kb < 8; ++kb)
#pragma unroll
            for (int j = 0; j < 4; ++j) so[(16 * kb + 4 * fq + j) * 128 + 16 * wid + fr] = S[kb][j]; }
}

#define XB_TMO      128
#define XB_XCNT(j)  (256  + 64 * (j))
#define XB_XSUB(j)  (1280 + 64 * (j))
#define XB_XGEN(j)  (2304 + 64 * (j))
#define XB_TOP      3328
#define XB_TOPGEN   3392
#define XCD_BAR_WORDS 3456
#define XB_SPIN_CAP (1u << 18)

__device__ __forceinline__ unsigned xb_ld(unsigned* p)              { return __hip_atomic_load(p, __ATOMIC_RELAXED, __HIP_MEMORY_SCOPE_AGENT); }
__device__ __forceinline__ unsigned xb_add(unsigned* p, unsigned v) { return __hip_atomic_fetch_add(p, v, __ATOMIC_RELAXED, __HIP_MEMORY_SCOPE_AGENT); }
__device__ __forceinline__ unsigned xb_xcc_id() { return (unsigned)__builtin_amdgcn_s_getreg((3 << 11) | 20) & 0xFu; }
#define XB_SPIN(cond, bar) do { unsigned _sp = 0; while (cond) { __builtin_amdgcn_s_sleep(1); \
    if ((++_sp & 255u) == 0u) { if (xb_ld(&(bar)[XB_TMO])) break; if (_sp > XB_SPIN_CAP) { atomicAdd(&(bar)[XB_TMO], 1u); break; } } } } while (0)

struct XcdBarrier {
    unsigned* bar; unsigned x;
    volatile LAS unsigned* st;
};

__device__ __forceinline__ XcdBarrier xcd_barrier_post(unsigned* bar, volatile LAS unsigned* st) {
    XcdBarrier b; b.bar = bar; b.x = xb_xcc_id(); b.st = st;
    if (threadIdx.x == 0) st[2] = xb_add(&bar[XB_XCNT(b.x)], 1u);
    return b;
}
__device__ __forceinline__ void xcd_barrier_complete(unsigned* bar, unsigned x, unsigned& nloc, unsigned& nx) {
    const unsigned G = gridDim.x * gridDim.y * gridDim.z;
    unsigned sum, cnt, mine, sp = 0u;
    for (;;) {
        sum = 0u; cnt = 0u; mine = 0u;
#pragma unroll
        for (unsigned j = 0; j < 16; ++j) { const unsigned c = xb_ld(&bar[XB_XCNT(j)]); sum += c; cnt += (c > 0u) ? 1u : 0u; mine = (j == x) ? c : mine; }
        if (sum == G) break;
        __builtin_amdgcn_s_sleep(1);
        if ((++sp & 255u) == 0u) { if (xb_ld(&bar[XB_TMO])) break; if (sp > XB_SPIN_CAP) { atomicAdd(&bar[XB_TMO], 1u); break; } }
    }
    nloc = mine > 0u ? mine : 1u; nx = cnt > 0u ? cnt : 1u;
}

__device__ __forceinline__ void xcd_barrier(const XcdBarrier& b) {
    asm volatile("s_waitcnt vmcnt(0)" ::: "memory");
    __syncthreads();
    if (threadIdx.x == 0) {
        unsigned* bar = b.bar;
        __builtin_amdgcn_s_waitcnt(0);
        unsigned nloc = b.st[0], nx = b.st[1];
        if (nloc == 0u) { xcd_barrier_complete(bar, b.x, nloc, nx); b.st[0] = nloc; b.st[1] = nx; }
        const unsigned old = xb_add(&bar[XB_XSUB(b.x)], 1u);
        const unsigned gen = old / nloc;
        if (old + 1u == (gen + 1u) * nloc) {
            __builtin_amdgcn_fence(__ATOMIC_RELEASE, "agent");
            asm volatile("s_waitcnt vmcnt(0)" ::: "memory");
            const unsigned og = xb_add(&bar[XB_TOP], 1u);
            const unsigned tg = og / nx;
            if (og + 1u == (tg + 1u) * nx) xb_add(&bar[XB_TOPGEN], 1u);
            else XB_SPIN(xb_ld(&bar[XB_TOPGEN]) == tg, bar);
            __builtin_amdgcn_fence(__ATOMIC_ACQUIRE, "agent");
            xb_add(&bar[XB_XGEN(b.x)], 1u);
            asm volatile("s_waitcnt vmcnt(0)" ::: "memory");
        } else {
            XB_SPIN(xb_ld(&bar[XB_XGEN(b.x)]) == gen, bar);
            __builtin_amdgcn_fence(__ATOMIC_ACQUIRE, "agent");
            asm volatile("s_waitcnt vmcnt(0)" ::: "memory");
        }
    }
    __syncthreads();
}

template <int ACT>
__device__ __forceinline__ void run_gemm(LAS unsigned char* lds, const bf16_t* A, const bf16_t* Bt, int N, int K, bf16_t* O, int ldc, const float* aux = nullptr) {
    const int vc = (int)((volatile LAS unsigned*)(lds + LDS_BYTES - 16))[3];
    pg8::Gemm g{A, Bt, NT, N, K}; pg8::StaticOrder S; S.init(NT, N, (int)gridDim.x, vc);
    pg8::EpiBf16<ACT> E{O, ldc, aux};
    pg8::gemm_phase<pg8::EpiBf16<ACT>, pg8::StaticOrder, true, true>(lds, g, S, E);
    if (PROBE_GEMM2) { __syncthreads(); pg8::gemm_phase<pg8::EpiBf16<ACT>, pg8::StaticOrder, true, true>(lds, g, S, E); }
}

__global__ void __launch_bounds__(NTHREADS, 2) fwd_megakernel(Params Pval) {
    extern __shared__ __attribute__((aligned(16))) unsigned char lds_raw[];
    LAS unsigned char* lds = (LAS unsigned char*)lds_raw;
    cg::grid_group grid = cg::this_grid();
    CPP Pk = (CPP)__builtin_amdgcn_kernarg_segment_ptr();
    if (threadIdx.x < 4) ((LAS unsigned*)(lds + LDS_BYTES - 16))[threadIdx.x] = 0u;
    __syncthreads();
    const XcdBarrier xbar = xcd_barrier_post((unsigned*)(Pval.ws + WS_BAR), (volatile LAS unsigned*)(lds + LDS_BYTES - 16));
#define PH_BEGIN CPP P = Pk; FRESH(P); int tid_ = threadIdx.x; asm volatile("" : "+v"(tid_)); const int tid = tid_, lane = tid & 63, wave = __builtin_amdgcn_readfirstlane(tid >> 6); const int G = gridDim.x, bid = blockIdx.x, gw = bid * 8 + wave, ngw = G * 8; \
    unsigned char* ws = P->ws; float* X = P->out; float* mod = (float*)(ws + WS_MOD); const float* norm_g = P->in[8]; LAS float* scr = (LAS float*)(lds + 65536 + wave * 8448); \
    (void)lane; (void)gw; (void)ngw; (void)X; (void)mod; (void)norm_g; (void)scr; (void)bid; (void)G;
#define W1_0 ((bf16_t*)(P->out + OUT_SH))
#define W2_0 (W1_0 + (size_t)4096 * 1024)
#define WGIN ((bf16_t*)(ws + WS_170))
#define WOUT0 ((bf16_t*)(ws + WS_WOUT0))
#define WOUT1 ((bf16_t*)(ws + WS_WOUT1))
    { PH_BEGIN
      for (int it = bid; it < 192; it += G) mod_item(P, lds, it);
      convert_matrix(P->in[9], 1024, 4128, WGIN, scr, gw, ngw, lane);
      for (int i = bid * NTHREADS + tid; i < 224 * 1024 / 8; i += G * NTHREADS) *(u32x4*)(WGIN + (size_t)4128 * 1024 + (size_t)i * 8) = (u32x4){0u, 0u, 0u, 0u};
 }
    if (Pval.ws == nullptr) grid.sync();
    xcd_barrier(xbar); if (PROBE_SYNC2) xcd_barrier(xbar);
    { volatile LAS unsigned* ctl = (volatile LAS unsigned*)(lds + LDS_BYTES - 16);
      if (threadIdx.x == 0) { unsigned* bar = (unsigned*)(Pval.ws + WS_BAR); const unsigned Gn = gridDim.x; bool ok = (Gn % 8u) == 0u; unsigned npop = 0u;
#pragma unroll
          for (unsigned j = 0; j < 16; ++j) { const unsigned cnt = xb_ld(&bar[XB_XCNT(j)]); if (j < 8) { ok = ok && (cnt == Gn / 8u); npop += (cnt > 0u) ? 1u : 0u; } else ok = ok && (cnt == 0u); }
          ok = ok && (npop == 8u) && (xbar.x < 8u) && (ctl[2] < Gn / 8u);
          ctl[3] = ok ? (xbar.x + 8u * ctl[2]) : (unsigned)blockIdx.x; }
      __syncthreads(); }
    { PH_BEGIN EwArgs A{P->in[0], P->in[1], nullptr, 0, 0, nullptr, 0, nullptr, nullptr, 0, norm_g + 0 * 1024, mod, 1024, 0, (bf16_t*)(ws + WS_210)}; ew_phase<0, 0>(A, gw, ngw, lane); }
    xcd_barrier(xbar); if (PROBE_SYNC2) xcd_barrier(xbar);
    { PH_BEGIN run_gemm<3>(lds, (const bf16_t*)(ws + WS_210), WGIN, LD0, 1024, (bf16_t*)(ws + WS_BIG), LD0); }
    xcd_barrier(xbar); if (PROBE_SYNC2) xcd_barrier(xbar);
    { PH_BEGIN conv_phase(lds, P, bid, G); }
    xcd_barrier(xbar);
    { PH_BEGIN for (int rnd = 0;; ++rnd) { const int it = scan_item_of(rnd, bid, G); if (it < 0) break; gdn_item(lds, P, it); BLOCK_SYNC(); if (PROBE_GDN2) { gdn_item(lds, P, it); BLOCK_SYNC(); } }
      { const bool half = (G == 256); const int cgw = half ? gw - 128 * 8 : gw, cngw = half ? 128 * 8 : ngw;
        if (cgw >= 0) { convert_matrix(P->in[14], 1024, 1024, WOUT0, scr, cgw, cngw, lane); convert_matrix(P->in[18], 1024, 1024, WOUT1, scr, cgw, cngw, lane);
                        convert_matrix(P->in[19], 1024, 4096, W1_0, scr, cgw, cngw, lane); convert_matrix(P->in[20], 4096, 1024, W2_0, scr, cgw, cngw, lane); } } }
    xcd_barrier(xbar); if (PROBE_SYNC2) xcd_barrier(xbar);
    { PH_BEGIN gate_phase((const bf16_t*)(ws + WS_170), DM, (const bf16_t*)(ws + WS_210), DM, (const bf16_t*)(ws + WS_BIG) + 3072, LD0, P->in[13], (bf16_t*)(ws + WS_170), gw, ngw, lane); }
    xcd_barrier(xbar); if (PROBE_SYNC2) xcd_barrier(xbar);
    { PH_BEGIN run_gemm<0>(lds, (const bf16_t*)(ws + WS_170), WOUT0, 1024, 1024, (bf16_t*)(ws + WS_210), DM); }
    xcd_barrier(xbar); if (PROBE_SYNC2) xcd_barrier(xbar);
    { PH_BEGIN EwArgs A{P->in[0], P->in[1], X, 0, 1, (const bf16_t*)(ws + WS_210), DM, norm_g + 1 * 1024, mod, 2048, norm_g + 2 * 1024, mod, 4096, 3072, (bf16_t*)(ws + WS_170)}; ew_phase<0, 1>(A, gw, ngw, lane); }
    xcd_barrier(xbar); if (PROBE_SYNC2) xcd_barrier(xbar);
    { PH_BEGIN run_gemm<2>(lds, (const bf16_t*)(ws + WS_170), W1_0, 4096, 1024, (bf16_t*)(ws + WS_BIG), 4096); }
    xcd_barrier(xbar); if (PROBE_SYNC2) xcd_barrier(xbar);
    { PH_BEGIN run_gemm<0>(lds, (const bf16_t*)(ws + WS_BIG), W2_0, 1024, 4096, (bf16_t*)(ws + WS_160), DM); }
    xcd_barrier(xbar); if (PROBE_SYNC2) xcd_barrier(xbar);
    { PH_BEGIN EwArgs A{nullptr, nullptr, X, 1, 1, (const bf16_t*)(ws + WS_160), DM, norm_g + 3 * 1024, mod, 5120, norm_g + 4 * 1024, mod + 9 * 6144, 1024, 0, (bf16_t*)(ws + WS_200)}; ew_phase<1, 1>(A, gw, ngw, lane);
      convert_matrix(P->in[15], 1024, 5120, (bf16_t*)(ws + WS_240), scr, gw, ngw, lane); }
    xcd_barrier(xbar); if (PROBE_SYNC2) xcd_barrier(xbar);
    { PH_BEGIN run_gemm<4>(lds, (const bf16_t*)(ws + WS_200), (const bf16_t*)(ws + WS_240), LD1, 1024, (bf16_t*)(ws + WS_BIG), LD1, P->in[16]); }
    xcd_barrier(xbar); if (PROBE_SYNC2) xcd_barrier(xbar);
    { PH_BEGIN for (int rnd = 0;; ++rnd) { const int it = scan_item_of(rnd, bid, G); if (it < 0) break; if (PROBE_HGRN2) { hgrn_item<true>(lds, P, it); BLOCK_SYNC(); } hgrn_item<false>(lds, P, it); BLOCK_SYNC(); } }
    xcd_barrier(xbar); if (PROBE_SYNC2) xcd_barrier(xbar);
    { PH_BEGIN gate_phase((const bf16_t*)(ws + WS_BIG) + 1024, LD1, (const bf16_t*)(ws + WS_BIG) + 2048, LD1, (const bf16_t*)(ws + WS_BIG) + 4096, LD1, P->in[17], (bf16_t*)(ws + WS_200), gw, ngw, lane); }
    xcd_barrier(xbar); if (PROBE_SYNC2) xcd_barrier(xbar);
    { PH_BEGIN run_gemm<0>(lds, (const bf16_t*)(ws + WS_200), WOUT1, 1024, 1024, (bf16_t*)(ws + WS_BIG), DM); }
    xcd_barrier(xbar); if (PROBE_SYNC2) xcd_barrier(xbar);
    { PH_BEGIN EwArgs A{nullptr, nullptr, X, 1, 1, (const bf16_t*)(ws + WS_BIG), DM, norm_g + 5 * 1024, mod + 9 * 6144, 2048, norm_g + 6 * 1024, mod + 9 * 6144, 4096, 3072, (bf16_t*)(ws + WS_200)}; ew_phase<1, 1>(A, gw, ngw, lane);
      convert_matrix(P->in[19] + (size_t)1024 * 4096, 1024, 4096, (bf16_t*)(ws + WS_168), scr, gw, ngw, lane);
      convert_matrix(P->in[20] + (size_t)4096 * 1024, 4096, 1024, (bf16_t*)(ws + WS_160), scr, gw, ngw, lane); }
    xcd_barrier(xbar); if (PROBE_SYNC2) xcd_barrier(xbar);
    { PH_BEGIN run_gemm<2>(lds, (const bf16_t*)(ws + WS_200), (const bf16_t*)(ws + WS_168), 4096, 1024, (bf16_t*)(ws + WS_BIG), 4096); }
    xcd_barrier(xbar); if (PROBE_SYNC2) xcd_barrier(xbar);
    { PH_BEGIN run_gemm<0>(lds, (const bf16_t*)(ws + WS_BIG), (const bf16_t*)(ws + WS_160), 1024, 4096, (bf16_t*)(ws + WS_200), DM); }
    xcd_barrier(xbar); if (PROBE_SYNC2) xcd_barrier(xbar);
    { PH_BEGIN EwArgs A{nullptr, nullptr, X, 1, 0, (const bf16_t*)(ws + WS_200), DM, norm_g + 7 * 1024, mod + 9 * 6144, 5120, nullptr, nullptr, 0, 0, nullptr}; ew_phase<1, 2>(A, gw, ngw, lane); }
}

extern "C" void kernel_launch(void* const* d_in, const int* in_sizes, int n_in, void* d_out, int out_size, void* d_ws, size_t ws_size, hipStream_t stream) {
    static int grid = 0;
    if (grid == 0) {
        if (n_in != 21 || ws_size < WS_NEED) { fprintf(stderr, "kernel_launch: need 21 inputs and >= %zu bytes of workspace (got %d, %zu)\n", (size_t)WS_NEED, n_in, ws_size); grid = -1; return; }
        int dev = 0, cus = 0, per_cu = 0;
        hipGetDevice(&dev); hipDeviceGetAttribute(&cus, hipDeviceAttributeMultiprocessorCount, dev);
        hipFuncSetAttribute((const void*)fwd_megakernel, hipFuncAttributeMaxDynamicSharedMemorySize, LDS_BYTES);
        hipOccupancyMaxActiveBlocksPerMultiprocessor(&per_cu, (const void*)fwd_megakernel, NTHREADS, LDS_BYTES);
        if (per_cu < 1) { fprintf(stderr, "kernel_launch: occupancy query reports %d blocks per CU\n", per_cu); per_cu = 1; }
        grid = cus * 1;
        (void)hipGetLastError();
    }
    if (grid < 0) return;
    Params p{};
    for (int i = 0; i < 21; ++i) p.in[i] = (const float*)d_in[i];
    p.out = (float*)d_out; p.ws = (unsigned char*)d_ws;
    if (hipMemsetAsync((char*)d_ws + WS_BAR, 0, BAR_BYTES, stream) != hipSuccess) { fprintf(stderr, "kernel_launch: memset of barrier words failed\n"); return; }
    void* args[] = {&p};
    hipError_t e = hipLaunchCooperativeKernel((const void*)fwd_megakernel, dim3(grid), dim3(NTHREADS), args, LDS_BYTES, stream);
    if (e != hipSuccess) fprintf(stderr, "cooperative launch failed: %s (grid %d)\n", hipGetErrorString(e), grid);
}
```
